# Optimizing an MI355X kernel written in HIP

```python
import jax, jax.numpy as jnp
from jax import lax
import numpy as np

D_MODEL = 1024
BATCH = 8
SEQ = 2048
DEPTH = 2

MEM_LEN = 256
XA_HEADS = 4
XA_HEAD_DIM = D_MODEL // XA_HEADS
D_FF = 2816
FOURIER_WIDTH = D_MODEL // 2
FOURIER_GROUPS = 4
FOURIER_GC = FOURIER_WIDTH // FOURIER_GROUPS
CONV_WIDTH = D_MODEL // 2
CONV_GROUPS = 4
CONV_GC = CONV_WIDTH // CONV_GROUPS
CONFORMER_K = 31
EVEN_IN = FOURIER_WIDTH + 2 * CONV_WIDTH
EVEN_MIX = FOURIER_WIDTH + CONV_WIDTH
SHORT_WIDTH = D_MODEL
SHORT_K = 3
N_EVEN = (DEPTH + 1) // 2
N_ODD = DEPTH // 2
N_NORMS = 8
EPS = 1e-6
HALF = 0.5

kernel_name = "hybrid_fourier_conformer_shortconv_encoder"


def rms_norm(x, g):
    xf = x.astype(jnp.float32)
    y = xf * lax.rsqrt(jnp.mean(xf * xf, axis=-1, keepdims=True) + EPS)
    return (y * g.astype(jnp.float32)).astype(x.dtype)


def swiglu(x, w_gate, w_up, w_down):
    return (jax.nn.silu(x @ w_gate) * (x @ w_up)) @ w_down


def depthwise_conv(u, w):
    k = w.shape[0]
    pad = (k - 1) // 2
    return lax.conv_general_dilated(
        u, w[:, None, :].astype(u.dtype), window_strides=(1,),
        padding=((pad, k - 1 - pad),),
        dimension_numbers=("NWC", "WIO", "NWC"),
        feature_group_count=u.shape[-1])


def fourier_mix(u, w):
    b, s, _ = u.shape
    ug = u.reshape(b, s, FOURIER_GROUPS, FOURIER_GC).astype(jnp.float32)
    f = jnp.fft.fft2(ug, axes=(1, 3), norm="ortho").real.astype(u.dtype)
    y = jnp.einsum("bsgc,gcd->bsgd", f, w)
    return y.reshape(b, s, FOURIER_WIDTH)


def group_layer_norm(u, g, beta):
    b, s, _ = u.shape
    uf = u.reshape(b, s, CONV_GROUPS, CONV_GC).astype(jnp.float32)
    mu = jnp.mean(uf, axis=-1, keepdims=True)
    var = jnp.mean(jnp.square(uf - mu), axis=-1, keepdims=True)
    y = ((uf - mu) * lax.rsqrt(var + EPS)).reshape(b, s, CONV_WIDTH)
    return (y * g.astype(jnp.float32) + beta.astype(jnp.float32)).astype(u.dtype)


def even_mixer(h, w_in, fourier_w, dw_w, dw_b, gn_g, gn_b, w_out):
    z = h @ w_in
    u_f = z[..., :FOURIER_WIDTH]
    u_val = z[..., FOURIER_WIDTH:FOURIER_WIDTH + CONV_WIDTH]
    u_gate = z[..., FOURIER_WIDTH + CONV_WIDTH:]
    y_a = fourier_mix(u_f, fourier_w)
    c = u_val * jax.nn.sigmoid(u_gate)
    c = depthwise_conv(c, dw_w) + dw_b
    y_b = jax.nn.silu(group_layer_norm(c, gn_g, gn_b))
    return jnp.concatenate([y_a, y_b], axis=-1) @ w_out


def odd_mixer(h, w_in, conv_w, w_out):
    z = h @ w_in
    b_gate, c_gate, v = jnp.split(z, 3, axis=-1)
    y = b_gate * depthwise_conv(c_gate * v, conv_w)
    return y @ w_out


def cross_attention(h, m, wq, wkv, wo):
    b, s, _ = h.shape
    q = (h @ wq).reshape(b, s, XA_HEADS, XA_HEAD_DIM)
    kv = m @ wkv
    k, v = jnp.split(kv, 2, axis=-1)
    k = k.reshape(b, MEM_LEN, XA_HEADS, XA_HEAD_DIM)
    v = v.reshape(b, MEM_LEN, XA_HEADS, XA_HEAD_DIM)
    scores = jnp.einsum("bshd,bmhd->bhsm", q.astype(jnp.float32),
                        k.astype(jnp.float32)) * (XA_HEAD_DIM ** -0.5)
    p = jax.nn.softmax(scores, axis=-1).astype(h.dtype)
    o = jnp.einsum("bhsm,bmhd->bshd", p, v).reshape(b, s, D_MODEL)
    return o @ wo


def setup_inputs(seed: int = 0) -> dict:
    key = jax.random.key(seed)
    ks = jax.random.split(key, 24)
    f32 = jnp.float32

    def nrm(k, shape, fan_in):
        return jax.random.normal(k, shape, f32) * (fan_in ** -0.5)

    def gain(k, shape):
        return 1.0 + 0.05 * jax.random.normal(k, shape, f32)

    def bias(k, shape):
        return 0.02 * jax.random.normal(k, shape, f32)

    return {
        "x": jax.random.normal(ks[0], (BATCH, SEQ, D_MODEL), f32),
        "mem": jax.random.normal(ks[1], (BATCH, MEM_LEN, D_MODEL), f32),
        "norm_g": gain(ks[2], (DEPTH, N_NORMS, D_MODEL)),
        "mem_norm_g": gain(ks[3], (DEPTH, D_MODEL)),
        "ffn_w_gate": nrm(ks[4], (DEPTH, 2, D_MODEL, D_FF), D_MODEL),
        "ffn_w_up": nrm(ks[5], (DEPTH, 2, D_MODEL, D_FF), D_MODEL),
        "ffn_w_down": nrm(ks[6], (DEPTH, 2, D_FF, D_MODEL), D_FF),
        "xa_wq": nrm(ks[7], (DEPTH, D_MODEL, D_MODEL), D_MODEL),
        "xa_wkv": nrm(ks[8], (DEPTH, D_MODEL, 2 * D_MODEL), D_MODEL),
        "xa_wo": nrm(ks[9], (DEPTH, D_MODEL, D_MODEL), D_MODEL),
        "ev_w_in": nrm(ks[10], (N_EVEN, D_MODEL, EVEN_IN), D_MODEL),
        "ev_fourier_w": nrm(ks[11], (N_EVEN, FOURIER_GROUPS, FOURIER_GC, FOURIER_GC), FOURIER_GC),
        "ev_dw_w": nrm(ks[12], (N_EVEN, CONFORMER_K, CONV_WIDTH), CONFORMER_K),
        "ev_dw_b": bias(ks[13], (N_EVEN, CONV_WIDTH)),
        "ev_gn_g": gain(ks[14], (N_EVEN, CONV_WIDTH)),
        "ev_gn_b": bias(ks[15], (N_EVEN, CONV_WIDTH)),
        "ev_w_out": nrm(ks[16], (N_EVEN, EVEN_MIX, D_MODEL), EVEN_MIX),
        "od_w_in": nrm(ks[17], (N_ODD, D_MODEL, 3 * SHORT_WIDTH), D_MODEL),
        "od_conv_w": nrm(ks[18], (N_ODD, SHORT_K, SHORT_WIDTH), SHORT_K),
        "od_w_out": nrm(ks[19], (N_ODD, SHORT_WIDTH, D_MODEL), SHORT_WIDTH),
    }


def reference(x, mem, norm_g, mem_norm_g, ffn_w_gate, ffn_w_up, ffn_w_down,
              xa_wq, xa_wkv, xa_wo, ev_w_in, ev_fourier_w, ev_dw_w, ev_dw_b,
              ev_gn_g, ev_gn_b, ev_w_out, od_w_in, od_conv_w, od_w_out):
    for l in range(DEPTH):
        g = norm_g[l]
        h = swiglu(rms_norm(x, g[0]), ffn_w_gate[l, 0], ffn_w_up[l, 0], ffn_w_down[l, 0])
        x = x + HALF * rms_norm(h, g[1])
        h = rms_norm(x, g[2])
        i = l // 2
        if l % 2 == 0:
            h = even_mixer(h, ev_w_in[i], ev_fourier_w[i], ev_dw_w[i], ev_dw_b[i],
                           ev_gn_g[i], ev_gn_b[i], ev_w_out[i])
        else:
            h = odd_mixer(h, od_w_in[i], od_conv_w[i], od_w_out[i])
        x = x + rms_norm(h, g[3])
        m = rms_norm(mem, mem_norm_g[l])
        h = cross_attention(rms_norm(x, g[4]), m, xa_wq[l], xa_wkv[l], xa_wo[l])
        x = x + rms_norm(h, g[5])
        h = swiglu(rms_norm(x, g[6]), ffn_w_gate[l, 1], ffn_w_up[l, 1], ffn_w_down[l, 1])
        x = x + HALF * rms_norm(h, g[7])
    return x
```

```cpp
#include <hip/hip_runtime.h>
#include <hip/hip_cooperative_groups.h>
#include <cstdio>
#include <cstdint>
namespace cg = cooperative_groups;
namespace pg8 {
#define PG8_LAS __attribute__((address_space(3)))
typedef unsigned short bf16_t;
typedef short bf16x8 __attribute__((ext_vector_type(8)));
typedef float f32x4 __attribute__((ext_vector_type(4)));
typedef unsigned u32x4 __attribute__((ext_vector_type(4)));
constexpr int BM = 256, BK = 64, HALF = 128, HTB = HALF * BK * 2  , STAGE_BYTES = 8 * HTB, NXCD = 8, WGM = 8;

__host__ __device__ __forceinline__ int lds_byte(int r, int c) { const int st = (r >> 4) * 2 + (c >> 5), rr = r & 15, cc = c & 31, ob = rr * 64 + cc * 2; return st * 1024 + (ob ^ (((ob >> 9) & 1) << 5)); }
__host__ __device__ __forceinline__ void stage_rc(int b, int& R, int& C) { const int st = b / 1024, sb = b % 1024, swz = sb ^ (((sb >> 9) & 1) << 5); R = (st >> 1) * 16 + swz / 64; C = (st & 1) * 32 + (swz % 64) / 2; }
__host__ __device__ __forceinline__ int perm32(int rho) { const int n = rho >> 4, i = rho & 15; return 8 * (i >> 2) + 4 * n + (i & 3); }

struct Unit { int pm, pn; };
struct Gemm { const bf16_t* A; const bf16_t* Bt; int M, N, K, a_mod; };

struct StaticOrder {
    int nM, nN, nwg, G, c;
    __host__ __device__ void init(int M, int N, int G_, int c_) { nM = M / BM; nN = N / BM; nwg = nM * nN; G = G_; c = c_; }
    __host__ __device__ bool next(int i, Unit& u) const {
        const long L = (long)i * G + c; if (L >= nwg) return false;
        int wgid = (int)L; { const int q = nwg / NXCD, r = nwg % NXCD, xcd = wgid % NXCD, off = wgid / NXCD; wgid = (xcd < r ? xcd * (q + 1) : r * (q + 1) + (xcd - r) * q) + off; }
        const int nig = WGM * nN, gid = wgid / nig, fm = gid * WGM, gsz = (nM - fm) < WGM ? (nM - fm) : WGM;
        u.pm = fm + ((wgid % nig) % gsz); u.pn = (wgid % nig) / gsz; return true;
    }
    __device__ __forceinline__ void a_ready(const Unit&) const {}
    __device__ __forceinline__ void done(const Unit&) const {}
};

__device__ __forceinline__ unsigned cvt_pk_bf16(float lo, float hi) { unsigned r; asm volatile("v_cvt_pk_bf16_f32 %0, %1, %2" : "=v"(r) : "v"(lo), "v"(hi)); return r; }
typedef float f32x2 __attribute__((ext_vector_type(2)));
typedef float f32x2 __attribute__((ext_vector_type(2)));
constexpr float NORM_EPS = 1e-6f;
__device__ __forceinline__ float rstd_of(float ss) { return __builtin_amdgcn_rsqf(ss * (1.0f / 1024.0f) + NORM_EPS); }
__device__ __forceinline__ float fast_sigmoid(float v) { return __builtin_amdgcn_rcpf(1.0f + __expf(-v)); }
__device__ __forceinline__ const char* aptr(const Gemm& g, const Unit& u) { return (const char*)g.A + (size_t)(u.pm % g.a_mod) * ((size_t)BM * g.K * 2); }
__device__ __forceinline__ const char* bptr(const Gemm& g, const Unit& u) { return (const char*)g.Bt + (size_t)((u.pm / g.a_mod) * (g.N / BM) + u.pn) * ((size_t)BM * g.K * 2); }

struct EpiG {
    static constexpr bool PERM = true, AFTER_DRAIN = false;
    int mode, act; bf16_t* O; int ldc; const float* ss; float* ssout; int cdiv; long cbatch; int rdiv; long rsplit;
    __device__ __forceinline__ void operator()(const f32x4 (&acc)[2][2][4][2], const Unit& u, int wr, int wc, int fr, int fq) const {
        const int row0 = u.pm * BM + wr * 64 + fr;
        if (mode == 0 || mode == 2) {
            const int col0 = u.pn * BM + wc * 32 + 8 * fq;
#pragma unroll
            for (int ai = 0; ai < 2; ++ai)
#pragma unroll
                for (int m = 0; m < 4; ++m) {
                    const int row = row0 + ai * HALF + m * 16;
                    const float rs = ss ? rstd_of(ss[row]) : 1.0f;
                    float sq = 0.f;
                    bf16_t* rowp = O + (size_t)row * ldc + col0;
#pragma unroll
                    for (int bj = 0; bj < 2; ++bj) {
                        f32x4 v0 = acc[ai][bj][m][0] * rs, v1 = acc[ai][bj][m][1] * rs;
                        sq += (v0[0] * v0[0] + v0[1] * v0[1]) + (v0[2] * v0[2] + v0[3] * v0[3]) + (v1[0] * v1[0] + v1[1] * v1[1]) + (v1[2] * v1[2] + v1[3] * v1[3]);
                        u32x4 w; w.x = cvt_pk_bf16(v0[0], v0[1]); w.y = cvt_pk_bf16(v0[2], v0[3]); w.z = cvt_pk_bf16(v1[0], v1[1]); w.w = cvt_pk_bf16(v1[2], v1[3]);
                        *(u32x4*)(rowp + bj * HALF) = w;
                    }
                    if (mode == 2) { sq += __shfl_xor(sq, 16); sq += __shfl_xor(sq, 32); if (fq == 0) ssout[(size_t)row * 16 + u.pn * 4 + wc] = sq; }
                }
        } else if (mode == 1) {
            const int col0 = u.pn * HALF + wc * 32 + 8 * fq;
#pragma unroll
            for (int ai = 0; ai < 2; ++ai)
#pragma unroll
                for (int m = 0; m < 4; ++m) {
                    const int row = row0 + ai * HALF + m * 16;
                    const float rs = ss ? rstd_of(ss[row]) : 1.0f;
                    float o[8];
#pragma unroll
                    for (int n = 0; n < 2; ++n)
#pragma unroll
                        for (int j = 0; j < 4; ++j) {
                            const float a = acc[ai][0][m][n][j] * rs, b = acc[ai][1][m][n][j] * rs;
                            float r;
                            if (act == 0) r = a * fast_sigmoid(a) * b; else if (act == 1) r = a * fast_sigmoid(b); else r = a * b;
                            o[n * 4 + j] = r;
                        }
                    u32x4 w; w.x = cvt_pk_bf16(o[0], o[1]); w.y = cvt_pk_bf16(o[2], o[3]); w.z = cvt_pk_bf16(o[4], o[5]); w.w = cvt_pk_bf16(o[6], o[7]);
                    *(u32x4*)(O + (size_t)row * ldc + col0) = w;
                }
        } else {
            bf16_t* base = O + (size_t)(u.pn / cdiv) * cbatch + (size_t)(u.pn % cdiv) * BM + (size_t)(u.pm / rdiv) * rsplit + (size_t)(u.pm % rdiv) * BM * ldc;
            const int tok0 = u.pn * BM + wc * 32 + 8 * fq;
            f32x4 rsv[2][2];
#pragma unroll
            for (int bj = 0; bj < 2; ++bj)
#pragma unroll
                for (int n = 0; n < 2; ++n) { const f32x4 s4 = *(const f32x4*)(ss + tok0 + bj * HALF + 4 * n);
                    rsv[bj][n] = (f32x4){rstd_of(s4[0]), rstd_of(s4[1]), rstd_of(s4[2]), rstd_of(s4[3])}; }
#pragma unroll
            for (int ai = 0; ai < 2; ++ai)
#pragma unroll
                for (int m = 0; m < 4; ++m) {
                    const int rl = wr * 64 + fr + ai * HALF + m * 16;
                    bf16_t* rowp = base + (size_t)rl * ldc + wc * 32 + 8 * fq;
#pragma unroll
                    for (int bj = 0; bj < 2; ++bj) {
                        const f32x4 v0 = acc[ai][bj][m][0] * rsv[bj][0], v1 = acc[ai][bj][m][1] * rsv[bj][1];
                        u32x4 w; w.x = cvt_pk_bf16(v0[0], v0[1]); w.y = cvt_pk_bf16(v0[2], v0[3]); w.z = cvt_pk_bf16(v1[0], v1[1]); w.w = cvt_pk_bf16(v1[2], v1[3]);
                        *(u32x4*)(rowp + bj * HALF) = w;
                    }
                }
        }
    }
};
template <class Epi, class Sched, bool ALIGN_EPI = false, bool SP2 = false>
__device__ __forceinline__ void gemm_phase(PG8_LAS unsigned char* lds, const Gemm g, const Sched& S, const Epi& E) {
    int tid = threadIdx.x; asm volatile("" : "+v"(tid)); const int wid = __builtin_amdgcn_readfirstlane(tid >> 6), lane = tid & 63, wr = wid >> 2, wc = wid & 3, fr = lane & 15, fq = lane >> 4;
    const int K = g.K, nt = K / BK;
    unsigned voffA[2], voffB[2];
#pragma unroll
    for (int i = 0; i < 2; ++i) { int R, C; stage_rc(tid * 16 + i * 8192, R, C); const int Rb = Epi::PERM ? ((R & ~31) + perm32(R & 31)) : R;
        voffA[i] = (unsigned)(R * K + C) * 2u; voffB[i] = (unsigned)(Rb * K + C) * 2u; }
    const size_t kstep = (size_t)(BK * 2);
    const size_t hstep = (size_t)HALF * K * 2;
    const unsigned ldsw = (unsigned)wid * 1024u;
    const int aoff = lds_byte(wr * 64 + fr, fq * 8), boff = lds_byte(wc * 32 + fr, fq * 8);
#define PG8_SA(b, h) (((b) * 2 + (h)) * HTB)
#define PG8_SB(b, h) ((4 + (b) * 2 + (h)) * HTB)
#define PG8_STAGE(bufoff, gbase, voff) do { _Pragma("unroll") for (int _i = 0; _i < 2; ++_i) \
        __builtin_amdgcn_global_load_lds((const unsigned*)((const char*)(gbase) + (voff)[_i]), (PG8_LAS unsigned*)(lds + (bufoff) + ldsw + _i * 8192), 16, 0, 0); } while (0)
#define PG8_LDA(dst, b, h) do { _Pragma("unroll") for (int m = 0; m < 4; ++m) _Pragma("unroll") for (int k = 0; k < 2; ++k) dst[m][k] = *(const PG8_LAS bf16x8*)(lds + PG8_SA(b, h) + aoff + m * 2048 + k * 1024); } while (0)
#define PG8_LDB(dst, b, h) do { _Pragma("unroll") for (int n = 0; n < 2; ++n) _Pragma("unroll") for (int k = 0; k < 2; ++k) dst[n][k] = *(const PG8_LAS bf16x8*)(lds + PG8_SB(b, h) + boff + n * 2048 + k * 1024); } while (0)
#define PG8_MMA(ai, bj, At, Bt) do { __builtin_amdgcn_s_setprio(1); _Pragma("unroll") for (int m = 0; m < 4; ++m) _Pragma("unroll") for (int n = 0; n < 2; ++n) _Pragma("unroll") for (int k = 0; k < 2; ++k) \
        acc[ai][bj][m][n] = __builtin_amdgcn_mfma_f32_16x16x32_bf16(Bt[n][k], At[m][k], acc[ai][bj][m][n], 0, 0, 0); __builtin_amdgcn_s_setprio(0); } while (0)
#define PG8_WAIT_V(n) asm volatile("s_waitcnt vmcnt(" #n ")" ::: "memory")
#define PG8_WAIT_L(n) asm volatile("s_waitcnt lgkmcnt(" #n ")" ::: "memory")
#define PG8_BAR __builtin_amdgcn_s_barrier()
#define PG8_SCHED __builtin_amdgcn_sched_barrier(0)
    Unit cur, nxt; int ui = 0;
    if (!S.next(0, cur)) return;
    f32x4 acc[2][2][4][2];
#pragma unroll
    for (int a = 0; a < 2; ++a)
#pragma unroll
        for (int b = 0; b < 2; ++b)
#pragma unroll
            for (int m = 0; m < 4; ++m)
#pragma unroll
                for (int n = 0; n < 2; ++n) acc[a][b][m][n] = (f32x4){0.f, 0.f, 0.f, 0.f};
    bf16x8 At[4][2], B0[2][2], B1[2][2];
    const char* cA = aptr(g, cur); const char* cB = bptr(g, cur);
    S.a_ready(cur);
    if constexpr (SP2) {
        PG8_STAGE(PG8_SB(0, 0), cB, voffB); PG8_STAGE(PG8_SB(0, 1), cB + hstep, voffB); PG8_STAGE(PG8_SA(0, 0), cA, voffA); PG8_STAGE(PG8_SA(0, 1), cA + hstep, voffA);
        if (wr == 1) PG8_BAR;
        PG8_WAIT_V(2); PG8_BAR;
        PG8_STAGE(PG8_SB(1, 0), cB + kstep, voffB); PG8_STAGE(PG8_SA(1, 0), cA + kstep, voffA); PG8_STAGE(PG8_SB(1, 1), cB + hstep + kstep, voffB);
        PG8_WAIT_V(6); PG8_BAR;
    } else {
        PG8_STAGE(PG8_SB(0, 0), cB, voffB); PG8_STAGE(PG8_SA(0, 0), cA, voffA); PG8_STAGE(PG8_SB(0, 1), cB + hstep, voffB); PG8_STAGE(PG8_SA(0, 1), cA + hstep, voffA);
        if (wr == 1) PG8_BAR;
        PG8_WAIT_V(4); PG8_BAR;
        PG8_STAGE(PG8_SB(1, 0), cB + kstep, voffB); PG8_STAGE(PG8_SA(1, 0), cA + kstep, voffA); PG8_STAGE(PG8_SB(1, 1), cB + hstep + kstep, voffB);
        PG8_WAIT_V(6); PG8_BAR;
    }
    for (;;) {
        const bool has_next = S.next(ui + 1, nxt);
        const char* nA = has_next ? aptr(g, nxt) : cA; const char* nB = has_next ? bptr(g, nxt) : cB;
        for (int t = 0; t < nt; t += 2) {
            const bool last = (t == nt - 2);
            const char* a1 = cA + (size_t)(t + 1) * kstep;
            const char* a2 = last ? nA : cA + (size_t)(t + 2) * kstep; const char* b2 = last ? nB : cB + (size_t)(t + 2) * kstep;
            const char* a3 = a2 + kstep; const char* b3 = b2 + kstep;
            if (last && has_next) S.a_ready(nxt);
            if constexpr (SP2) {
            PG8_LDB(B0, 0, 0); PG8_LDB(B1, 0, 1); PG8_SCHED; PG8_LDA(At, 0, 0); PG8_STAGE(PG8_SA(1, 1), a1 + hstep, voffA);
            PG8_WAIT_V(8); PG8_WAIT_L(0); PG8_BAR; PG8_MMA(0, 0, At, B0); PG8_MMA(0, 1, At, B1); PG8_BAR; PG8_SCHED;
            PG8_LDA(At, 0, 1); PG8_STAGE(PG8_SB(0, 0), b2, voffB); PG8_STAGE(PG8_SB(0, 1), b2 + hstep, voffB); PG8_STAGE(PG8_SA(0, 0), a2, voffA);
            PG8_WAIT_V(8); PG8_WAIT_L(0); PG8_BAR; PG8_MMA(1, 0, At, B0); PG8_MMA(1, 1, At, B1); PG8_BAR; PG8_SCHED;
            PG8_LDB(B0, 1, 0); PG8_LDB(B1, 1, 1); PG8_SCHED; PG8_LDA(At, 1, 0); PG8_STAGE(PG8_SA(0, 1), a2 + hstep, voffA);
            PG8_WAIT_V(8); PG8_WAIT_L(0); PG8_BAR; PG8_MMA(0, 0, At, B0); PG8_MMA(0, 1, At, B1); PG8_BAR; PG8_SCHED;
            PG8_LDA(At, 1, 1); PG8_STAGE(PG8_SB(1, 0), b3, voffB); PG8_STAGE(PG8_SB(1, 1), b3 + hstep, voffB); PG8_STAGE(PG8_SA(1, 0), a3, voffA);
            PG8_WAIT_V(8); PG8_WAIT_L(0); PG8_BAR; PG8_MMA(1, 0, At, B0); PG8_MMA(1, 1, At, B1); PG8_BAR; PG8_SCHED;
            } else {
            PG8_LDB(B0, 0, 0); PG8_SCHED; PG8_LDA(At, 0, 0); PG8_STAGE(PG8_SA(1, 1), a1 + hstep, voffA);
            PG8_WAIT_L(8); PG8_BAR; PG8_WAIT_L(0); PG8_MMA(0, 0, At, B0); PG8_BAR; PG8_SCHED;
            PG8_LDB(B1, 0, 1); PG8_STAGE(PG8_SB(0, 0), b2, voffB);
            PG8_BAR; PG8_WAIT_L(0); PG8_MMA(0, 1, At, B1); PG8_BAR;
            PG8_LDA(At, 0, 1); PG8_STAGE(PG8_SA(0, 0), a2, voffA);
            PG8_BAR; PG8_WAIT_L(0); PG8_MMA(1, 0, At, B0); PG8_BAR; PG8_SCHED;
            PG8_STAGE(PG8_SB(0, 1), b2 + hstep, voffB);
            PG8_WAIT_V(6); PG8_BAR; PG8_MMA(1, 1, At, B1); PG8_BAR;
            PG8_LDB(B0, 1, 0); PG8_SCHED; PG8_LDA(At, 1, 0); PG8_STAGE(PG8_SA(0, 1), a2 + hstep, voffA);
            PG8_WAIT_L(8); PG8_BAR; PG8_WAIT_L(0); PG8_MMA(0, 0, At, B0); PG8_BAR; PG8_SCHED;
            PG8_LDB(B1, 1, 1); PG8_STAGE(PG8_SB(1, 0), b3, voffB);
            PG8_BAR; PG8_WAIT_L(0); PG8_MMA(0, 1, At, B1); PG8_BAR;
            PG8_LDA(At, 1, 1); PG8_STAGE(PG8_SA(1, 0), a3, voffA);
            PG8_BAR; PG8_WAIT_L(0); PG8_MMA(1, 0, At, B0); PG8_BAR; PG8_SCHED;
            PG8_STAGE(PG8_SB(1, 1), b3 + hstep, voffB);
            PG8_WAIT_V(6); PG8_BAR; PG8_MMA(1, 1, At, B1); PG8_BAR;
            }
        }
        if constexpr (ALIGN_EPI) { if (wr == 0) PG8_BAR; }
        if constexpr (!Epi::AFTER_DRAIN) { E(acc, cur, wr, wc, fr, fq); S.done(cur); }
        if (!has_next) break;
#pragma unroll
        for (int a = 0; a < 2; ++a)
#pragma unroll
            for (int b = 0; b < 2; ++b)
#pragma unroll
                for (int m = 0; m < 4; ++m)
#pragma unroll
                    for (int n = 0; n < 2; ++n) acc[a][b][m][n] = (f32x4){0.f, 0.f, 0.f, 0.f};
        cur = nxt; cA = nA; cB = nB; ++ui;
        if constexpr (ALIGN_EPI) { if (wr == 1) PG8_BAR; }
    }
    PG8_WAIT_V(0);
    if constexpr (!ALIGN_EPI) { if (wr == 0) PG8_BAR; }
    PG8_BAR;
    if constexpr (Epi::AFTER_DRAIN) { E.fused(acc, cur, wr, wc, fr, fq, lds, wid, lane); S.done(cur); }
#undef PG8_SA
#undef PG8_SB
#undef PG8_STAGE
#undef PG8_LDA
#undef PG8_LDB
#undef PG8_MMA
#undef PG8_WAIT_V
#undef PG8_WAIT_L
#undef PG8_BAR
#undef PG8_SCHED
}
}

#ifndef MK_PER_PHASE
#define MK_PER_PHASE 0
#endif
using pg8::bf16_t; using pg8::bf16x8; using pg8::f32x4; using pg8::u32x4;
typedef short s16x4 __attribute__((ext_vector_type(4)));
typedef unsigned u32x2 __attribute__((ext_vector_type(2)));
#define LAS __attribute__((address_space(3)))
constexpr int NWAVES = 8, NTHR = 512;
constexpr int T = 16384, D = 1024, FF = 2816, SEQ = 2048, NB = 8, MEMT = 2048;
constexpr size_t MiB = 1u << 20;
constexpr size_t WS_SSX = 0, WS_SSM = 131072, WS_G = 262144, WS_SSH = 1u << 20;
constexpr size_t WS_MEMB = 2 * MiB, WS_KV = 6 * MiB, WS_W = 22 * MiB;
constexpr size_t WS_WQ = 88 * MiB, WS_WINF = 104 * MiB, WS_WINVG = 106 * MiB, WS_WOUTEV = 108 * MiB, WS_WINCV = 110 * MiB, WS_WINB = 114 * MiB, WS_WOUTOD = 116 * MiB, WS_CMAT = 118 * MiB;
constexpr size_t WS_XB = 134 * MiB, WS_AR = 166 * MiB, WS_END = 254 * MiB;
constexpr int LDS_BYTES = 147456, TAB_OFF = 131072;
constexpr int NPHASE = 29;

struct Args { const float* in[20]; float* out; unsigned char* ws; int ph_lo, ph_hi; };

__device__ __forceinline__ float wave_sum(float v) {
#pragma unroll
    for (int o = 1; o < 64; o <<= 1) v += __shfl_xor(v, o);
    return v;
}
__device__ __forceinline__ unsigned pk2(float lo, float hi) { return pg8::cvt_pk_bf16(lo, hi); }
__device__ __forceinline__ float bf_lo(unsigned w) { return __uint_as_float(w << 16); }
__device__ __forceinline__ float bf_hi(unsigned w) { return __uint_as_float(w & 0xffff0000u); }

__device__ __forceinline__ void tr_item(const float* W, int ld, int K, int nsrc, bf16_t* WT, int drow, const float* gain, float scale, float* scr, int kb, int lane) {
    const int k0 = 64 * kb;
#pragma unroll 8
    for (int i = 0; i < 32; ++i) { const int kk = 2 * i + (lane >> 5); const float gsc = gain ? gain[k0 + kk] * scale : scale;
        scr[kk * 33 + (lane & 31)] = W[(size_t)(k0 + kk) * ld + nsrc + (lane & 31)] * gsc; }
    asm volatile("s_waitcnt lgkmcnt(0)" ::: "memory");
    const int c = lane & 7;
#pragma unroll
    for (int j = 0; j < 4; ++j) { const int n = (lane >> 3) + 8 * j; const float* s = scr + (8 * c) * 33 + n;
        u32x4 o; o.x = pk2(s[0 * 33], s[1 * 33]); o.y = pk2(s[2 * 33], s[3 * 33]); o.z = pk2(s[4 * 33], s[5 * 33]); o.w = pk2(s[6 * 33], s[7 * 33]);
        *(u32x4*)(WT + (size_t)(drow + n) * K + k0 + 8 * c) = o; }
    asm volatile("s_waitcnt lgkmcnt(0)" ::: "memory");
}

__device__ __forceinline__ void row_to_bf16_ss(const float* xrow, bf16_t* orow, float* ssp, int lane) {
    float s = 0.f;
#pragma unroll
    for (int j = 0; j < 4; ++j) { const f32x4 v = *(const f32x4*)(xrow + 256 * j + 4 * lane);
        s += (v[0] * v[0] + v[1] * v[1]) + (v[2] * v[2] + v[3] * v[3]);
        u32x2 o; o.x = pk2(v[0], v[1]); o.y = pk2(v[2], v[3]); *(u32x2*)(orow + 256 * j + 4 * lane) = o; }
    s = wave_sum(s);
    if (lane == 0) *ssp = s;
}

__device__ __forceinline__ void resid_phase(const float* xin, float* xout, bf16_t* hxb, float* SSH, float* SSX, const float* g, float alpha, int gw, int NGW, int lane) {
    for (int row = gw; row < T; row += NGW) {
        const float rs = pg8::rstd_of(wave_sum(lane < 16 ? SSH[(size_t)row * 16 + lane] : 0.f)) * alpha;
        float s = 0.f;
#pragma unroll
        for (int j = 0; j < 4; ++j) {
            const size_t off = (size_t)row * D + 256 * j + 4 * lane;
            const u32x2 hw = *(const u32x2*)(hxb + off);
            const f32x4 xv = *(const f32x4*)(xin + off);
            const f32x4 gv = *(const f32x4*)(g + 256 * j + 4 * lane);
            f32x4 o;
            o[0] = xv[0] + bf_lo(hw.x) * rs * gv[0]; o[1] = xv[1] + bf_hi(hw.x) * rs * gv[1];
            o[2] = xv[2] + bf_lo(hw.y) * rs * gv[2]; o[3] = xv[3] + bf_hi(hw.y) * rs * gv[3];
            s += (o[0] * o[0] + o[1] * o[1]) + (o[2] * o[2] + o[3] * o[3]);
            *(f32x4*)(xout + off) = o;
            u32x2 ob; ob.x = pk2(o[0], o[1]); ob.y = pk2(o[2], o[3]); *(u32x2*)(hxb + off) = ob;
        }
        s = wave_sum(s);
        if (lane == 0) SSX[row] = s;
    }
}

__device__ __forceinline__ void attn_phase(const bf16_t* Q, const bf16_t* Kb, const bf16_t* Vt, bf16_t* O, int G, int bid, int wave, int lane) {
    const int fr = lane & 15, fq = lane >> 4;
    for (int unit = bid; unit < 256; unit += G) {
        const int b = unit >> 5, h = (unit >> 3) & 3, qb = unit & 7;
        const int row0 = b * SEQ + qb * 256 + wave * 32;
        f32x4 S[2][16];
#pragma unroll
        for (int qt = 0; qt < 2; ++qt)
#pragma unroll
            for (int mt = 0; mt < 16; ++mt) S[qt][mt] = (f32x4){0.f, 0.f, 0.f, 0.f};
        const bf16_t* qp = Q + (size_t)(row0 + fr) * D + h * 256 + fq * 8;
        const bf16_t* kp = Kb + (size_t)(b * 256 + fr) * D + h * 256 + fq * 8;
#pragma unroll 1
        for (int ks = 0; ks < 8; ++ks) {
            const bf16x8 q0 = *(const bf16x8*)(qp + ks * 32), q1 = *(const bf16x8*)(qp + 16 * D + ks * 32);
#pragma unroll
            for (int mt = 0; mt < 16; ++mt) {
                const bf16x8 kf = *(const bf16x8*)(kp + (size_t)mt * 16 * D + ks * 32);
                S[0][mt] = __builtin_amdgcn_mfma_f32_16x16x32_bf16(kf, q0, S[0][mt], 0, 0, 0);
                S[1][mt] = __builtin_amdgcn_mfma_f32_16x16x32_bf16(kf, q1, S[1][mt], 0, 0, 0);
            }
        }
        float inv[2]; bf16x8 pf[2][8];
#pragma unroll
        for (int qt = 0; qt < 2; ++qt) {
            float mx = -3.0e38f;
#pragma unroll
            for (int mt = 0; mt < 16; ++mt)
#pragma unroll
                for (int r = 0; r < 4; ++r) mx = fmaxf(mx, S[qt][mt][r]);
            mx = fmaxf(mx, __shfl_xor(mx, 16)); mx = fmaxf(mx, __shfl_xor(mx, 32));
            float sum = 0.f;
#pragma unroll
            for (int mt = 0; mt < 16; ++mt)
#pragma unroll
                for (int r = 0; r < 4; ++r) { const float e = __expf(S[qt][mt][r] - mx); S[qt][mt][r] = e; sum += e; }
            sum += __shfl_xor(sum, 16); sum += __shfl_xor(sum, 32);
            inv[qt] = 1.0f / sum;
#pragma unroll
            for (int kc = 0; kc < 8; ++kc) {
                u32x4 w; w.x = pk2(S[qt][2 * kc][0], S[qt][2 * kc][1]); w.y = pk2(S[qt][2 * kc][2], S[qt][2 * kc][3]);
                w.z = pk2(S[qt][2 * kc + 1][0], S[qt][2 * kc + 1][1]); w.w = pk2(S[qt][2 * kc + 1][2], S[qt][2 * kc + 1][3]);
                pf[qt][kc] = __builtin_bit_cast(bf16x8, w);
            }
        }
        const bf16_t* vp = Vt + (size_t)(h * 256 + fr) * MEMT + b * 256 + 4 * fq;
        bf16_t* op = O + (size_t)(row0 + fr) * D + h * 256 + 4 * fq;
#pragma unroll 2
        for (int dt = 0; dt < 16; ++dt) {
            f32x4 o0 = (f32x4){0.f, 0.f, 0.f, 0.f}, o1 = (f32x4){0.f, 0.f, 0.f, 0.f};
#pragma unroll
            for (int kc = 0; kc < 8; ++kc) {
                const u32x2 lo = *(const u32x2*)(vp + (size_t)dt * 16 * MEMT + kc * 32), hi = *(const u32x2*)(vp + (size_t)dt * 16 * MEMT + kc * 32 + 16);
                u32x4 w; w.x = lo.x; w.y = lo.y; w.z = hi.x; w.w = hi.y;
                const bf16x8 vf = __builtin_bit_cast(bf16x8, w);
                o0 = __builtin_amdgcn_mfma_f32_16x16x32_bf16(vf, pf[0][kc], o0, 0, 0, 0);
                o1 = __builtin_amdgcn_mfma_f32_16x16x32_bf16(vf, pf[1][kc], o1, 0, 0, 0);
            }
            u32x2 w0, w1; w0.x = pk2(o0[0] * inv[0], o0[1] * inv[0]); w0.y = pk2(o0[2] * inv[0], o0[3] * inv[0]);
            w1.x = pk2(o1[0] * inv[1], o1[1] * inv[1]); w1.y = pk2(o1[2] * inv[1], o1[3] * inv[1]);
            *(u32x2*)(op + dt * 16) = w0; *(u32x2*)(op + 16 * D + dt * 16) = w1;
        }
    }
}

__device__ __forceinline__ void convln_phase(const bf16_t* C, bf16_t* Ycat, const float* dww, const float* dwb, const float* gng, const float* gnb, float* lds, int first, int nblk, int bid, int tid) {
    if (bid < first) return;
    const int wave = tid >> 6, lane = tid & 63;
    float* Cin = lds;
    float* Cout = lds + 94 * 128;
    for (int it = bid - first; it < 1024; it += nblk) {
        const int g = it & 3, sc = (it >> 2) & 31, b = it >> 7, s0 = sc * 64;
        for (int ch = tid; ch < 94 * 16; ch += NTHR) {
            const int r = ch >> 4, c8 = (ch & 15) * 8, s = s0 - 15 + r;
            f32x4 a = (f32x4){0.f, 0.f, 0.f, 0.f}, bb = a;
            if (s >= 0 && s < SEQ) { const u32x4 w = *(const u32x4*)(C + (size_t)(b * SEQ + s) * 512 + g * 128 + c8);
                a = (f32x4){bf_lo(w.x), bf_hi(w.x), bf_lo(w.y), bf_hi(w.y)}; bb = (f32x4){bf_lo(w.z), bf_hi(w.z), bf_lo(w.w), bf_hi(w.w)}; }
            *(f32x4*)(Cin + r * 128 + c8) = a; *(f32x4*)(Cin + r * 128 + c8 + 4) = bb;
        }
        __syncthreads();
        {
            const int ch = tid & 127, rg = tid >> 7;
            float w[31];
#pragma unroll
            for (int k = 0; k < 31; ++k) w[k] = dww[k * 512 + g * 128 + ch];
            const float bias = dwb[g * 128 + ch];
            float acc[16];
#pragma unroll
            for (int r = 0; r < 16; ++r) acc[r] = bias;
#pragma unroll
            for (int i = 0; i < 46; ++i) {
                const float v = Cin[(rg * 16 + i) * 128 + ch];
#pragma unroll
                for (int r = 0; r < 16; ++r) { if (i - r >= 0 && i - r < 31) acc[r] += v * w[i - r]; }
            }
#pragma unroll
            for (int r = 0; r < 16; ++r) Cout[(rg * 16 + r) * 128 + ch] = acc[r];
        }
        __syncthreads();
        {
            const float g0 = gng[g * 128 + 2 * lane], g1 = gng[g * 128 + 2 * lane + 1], b0 = gnb[g * 128 + 2 * lane], b1 = gnb[g * 128 + 2 * lane + 1];
#pragma unroll
            for (int rr = 0; rr < 8; ++rr) {
                const int r = wave * 8 + rr;
                const float v0 = Cout[r * 128 + 2 * lane], v1 = Cout[r * 128 + 2 * lane + 1];
                const float mu = wave_sum(v0 + v1) * (1.0f / 128.0f);
                const float d0 = v0 - mu, d1 = v1 - mu;
                const float var = wave_sum(d0 * d0 + d1 * d1) * (1.0f / 128.0f);
                const float rs = __builtin_amdgcn_rsqf(var + 1e-6f);
                float y0 = d0 * rs * g0 + b0, y1 = d1 * rs * g1 + b1;
                y0 = y0 * pg8::fast_sigmoid(y0); y1 = y1 * pg8::fast_sigmoid(y1);
                *(unsigned*)(Ycat + (size_t)(b * SEQ + s0 + r) * D + 512 + g * 128 + 2 * lane) = pk2(y0, y1);
            }
        }
        __syncthreads();
    }
}

__device__ __forceinline__ void conv3_phase(const bf16_t* CV, bf16_t* BG, const float* cw, int gw, int NGW, int lane) {
    for (int row = gw; row < T; row += NGW) {
        const int s = row & (SEQ - 1);
#pragma unroll
        for (int hlf = 0; hlf < 2; ++hlf) {
            const int c0 = hlf * 512 + 8 * lane;
            const size_t off = (size_t)row * D + c0;
            const u32x4 z = (u32x4){0u, 0u, 0u, 0u};
            const u32x4 cm = (s > 0) ? *(const u32x4*)(CV + off - D) : z;
            const u32x4 cc = *(const u32x4*)(CV + off);
            const u32x4 cp = (s < SEQ - 1) ? *(const u32x4*)(CV + off + D) : z;
            const u32x4 bg = *(const u32x4*)(BG + off);
            const f32x4 w0a = *(const f32x4*)(cw + c0), w0b = *(const f32x4*)(cw + c0 + 4);
            const f32x4 w1a = *(const f32x4*)(cw + D + c0), w1b = *(const f32x4*)(cw + D + c0 + 4);
            const f32x4 w2a = *(const f32x4*)(cw + 2 * D + c0), w2b = *(const f32x4*)(cw + 2 * D + c0 + 4);
            u32x4 ow;
#pragma unroll
            for (int j = 0; j < 4; ++j) {
                const float w00 = (j < 2) ? w0a[2 * j] : w0b[2 * j - 4], w01 = (j < 2) ? w0a[2 * j + 1] : w0b[2 * j - 3];
                const float w10 = (j < 2) ? w1a[2 * j] : w1b[2 * j - 4], w11 = (j < 2) ? w1a[2 * j + 1] : w1b[2 * j - 3];
                const float w20 = (j < 2) ? w2a[2 * j] : w2b[2 * j - 4], w21 = (j < 2) ? w2a[2 * j + 1] : w2b[2 * j - 3];
                const float y0 = bf_lo(bg[j]) * (w00 * bf_lo(cm[j]) + w10 * bf_lo(cc[j]) + w20 * bf_lo(cp[j]));
                const float y1 = bf_hi(bg[j]) * (w01 * bf_hi(cm[j]) + w11 * bf_hi(cc[j]) + w21 * bf_hi(cp[j]));
                ow[j] = pk2(y0, y1);
            }
            *(u32x4*)(BG + off) = ow;
        }
    }
}

__device__ __forceinline__ void fold_phase(const float* Win  , const float* Gm, const float* gain, bf16_t* WINF, float* lds, int G, int bid, int tid) {
    float* Gs = lds;
    float* Ws = lds + 16384;
    for (int it = bid; it < 128; it += G) {
        const int cs = it >> 6, g = (it >> 4) & 3, kb = it & 15, k0 = 64 * kb;
        const float* gsrc = Gm + (size_t)(g * 2 + cs) * 16384;
        for (int i = tid; i < 4096; i += NTHR) *(f32x4*)(Gs + 4 * i) = *(const f32x4*)(gsrc + 4 * i);
        for (int i = tid; i < 64 * 32; i += NTHR) { const int kk = i >> 5, c4 = (i & 31) * 4;
            f32x4 v = *(const f32x4*)(Win + (size_t)(k0 + kk) * 1536 + g * 128 + c4); v = v * gain[k0 + kk];
            *(f32x4*)(Ws + kk * 132 + c4) = v; }
        __syncthreads();
        const int d = tid & 127, kg = tid >> 7;
        float acc[16];
#pragma unroll
        for (int kk = 0; kk < 16; ++kk) acc[kk] = 0.f;
        for (int c = 0; c < 128; c += 4) {
            const float g0 = Gs[(c + 0) * 128 + d], g1 = Gs[(c + 1) * 128 + d], g2 = Gs[(c + 2) * 128 + d], g3 = Gs[(c + 3) * 128 + d];
#pragma unroll
            for (int kk = 0; kk < 16; ++kk) { const f32x4 w4 = *(const f32x4*)(Ws + (kg * 16 + kk) * 132 + c);
                acc[kk] += (w4[0] * g0 + w4[1] * g1) + (w4[2] * g2 + w4[3] * g3); }
        }
        bf16_t* dst = WINF + (size_t)(cs * 512 + g * 128 + d) * 1024 + k0 + kg * 16;
        u32x4 o0, o1;
        o0.x = pk2(acc[0], acc[1]); o0.y = pk2(acc[2], acc[3]); o0.z = pk2(acc[4], acc[5]); o0.w = pk2(acc[6], acc[7]);
        o1.x = pk2(acc[8], acc[9]); o1.y = pk2(acc[10], acc[11]); o1.z = pk2(acc[12], acc[13]); o1.w = pk2(acc[14], acc[15]);
        *(u32x4*)dst = o0; *(u32x4*)(dst + 8) = o1;
        __syncthreads();
    }
}

__global__ void __launch_bounds__(NTHR, 2) mk_fwd(Args a) {
    extern __shared__ __attribute__((aligned(16))) unsigned char lds[];
    cg::grid_group grid = cg::this_grid();
    const int G = gridDim.x, bid = blockIdx.x;
    const int NGW = G * NWAVES;
    const float* norm_g = a.in[2];

    for (int ph = a.ph_lo; ph < a.ph_hi; ++ph) {
    int tid = threadIdx.x; asm volatile("" : "+v"(tid));
    unsigned char* ws = a.ws; asm volatile("" : "+s"(ws));
    const int lane = tid & 63, wave = __builtin_amdgcn_readfirstlane(tid >> 6);
    const int gw = bid * NWAVES + wave;
    float* SSX = (float*)(ws + WS_SSX); float* SSH = (float*)(ws + WS_SSH); float* SSM = (float*)(ws + WS_SSM); float* GM = (float*)(ws + WS_G);
    bf16_t* MEMB = (bf16_t*)(ws + WS_MEMB);
    bf16_t* XB = (bf16_t*)(ws + WS_XB);
    bf16_t* AR = (bf16_t*)(ws + WS_AR);
    bf16_t* HB = AR;
    bf16_t* PT = AR; bf16_t* CGLU = AR + 16 * MiB; bf16_t* YCAT = AR + 24 * MiB;
    bf16_t* CV = AR; bf16_t* BG = AR + 16 * MiB;
    bf16_t* QB = AR; bf16_t* OB = AR + 16 * MiB;
    bf16_t* CMAT = (bf16_t*)(ws + WS_CMAT);
    bf16_t* WINF = (bf16_t*)(ws + WS_WINF);
        int nj = 0, l = 0, k = -1;
        if (ph == 0) {
            float* tab = (float*)(lds + TAB_OFF);
            for (int j = tid; j < 2048; j += NTHR) tab[j] = cospif((float)j * (1.0f / 1024.0f));
            __syncthreads();
            for (int it = bid; it < 64; it += G) {
                const int g = it >> 4, cs = (it >> 3) & 1, cb = it & 7, d = tid & 127, ci = tid >> 7;
                const float* Wf = a.in[11] + (size_t)g * 16384;
                float acc[4] = {0.f, 0.f, 0.f, 0.f};
                const int cbase = cb * 16 + ci * 4;
                for (int j = 0; j < 128; ++j) {
                    const float w = Wf[j * 128 + d];
#pragma unroll
                    for (int i = 0; i < 4; ++i) { const int idx = (j * (cbase + i)) & 127; acc[i] += tab[(16 * idx + (cs ? 1536 : 0)) & 2047] * w; }
                }
#pragma unroll
                for (int i = 0; i < 4; ++i) GM[(size_t)(g * 2 + cs) * 16384 + (cbase + i) * 128 + d] = acc[i] * (1.0f / 512.0f);
            }
            for (int kr = gw; kr < SEQ; kr += NGW) {
#pragma unroll
                for (int i = 0; i < 8; ++i) {
                    const int col = i * 512 + lane * 8, cs = col >> 11, s = col & 2047;
                    float v[8];
#pragma unroll
                    for (int e = 0; e < 8; ++e) v[e] = tab[(kr * (s + e) + (cs ? 512 : 0)) & 2047];
                    u32x4 o; o.x = pk2(v[0], v[1]); o.y = pk2(v[2], v[3]); o.z = pk2(v[4], v[5]); o.w = pk2(v[6], v[7]);
                    *(u32x4*)(CMAT + (size_t)kr * 4096 + col) = o;
                }
            }
            for (int row = gw; row < T; row += NGW) row_to_bf16_ss(a.in[0] + (size_t)row * D, XB + (size_t)row * D, SSX + row, lane);
            for (int row = gw; row < MEMT; row += NGW) row_to_bf16_ss(a.in[1] + (size_t)row * D, MEMB + (size_t)row * D, SSM + row, lane);
            float* scr = (float*)(lds + wave * 16384);
            int rotc = 0;
#define CONV_TASK(SRC, LD, KK, N0, NC, DST, INTER, BOFF, GAIN, SCALE) do { \
            const int nblk_ = (NC) / 32, nit_ = ((KK) / 64) * nblk_; \
            for (int it = (gw + NGW - (rotc % NGW)) % NGW; it < nit_; it += NGW) { const int kb_ = it / nblk_, n_ = 32 * (it % nblk_); \
                const int drow_ = (INTER) ? (256 * (n_ >> 7) + (n_ & 127) + (BOFF)) : (n_ + (BOFF)); \
                tr_item((SRC), (LD), (KK), (N0) + n_, (DST), drow_, (GAIN), (SCALE), scr, kb_, lane); } \
            rotc += nit_; } while (0)
            for (int ll = 0; ll < 2; ++ll) {
                for (int j = 0; j < 2; ++j) {
                    bf16_t* wgu = (bf16_t*)(ws + WS_W + (size_t)(ll * 2 + j) * (16 * MiB + MiB / 2));
                    bf16_t* wd = wgu + (size_t)5632 * 1024;
                    const float* gn = norm_g + (size_t)(ll * 8 + (j ? 6 : 0)) * D;
                    const size_t wo = (size_t)(ll * 2 + j) * D * FF;
                    CONV_TASK(a.in[4] + wo, FF, D, 0, FF, wgu, 1, 0, gn, 1.0f);
                    CONV_TASK(a.in[5] + wo, FF, D, 0, FF, wgu, 1, 128, gn, 1.0f);
                    CONV_TASK(a.in[6] + wo, D, FF, 0, D, wd, 0, 0, (const float*)nullptr, 1.0f);
                }
                bf16_t* wq = (bf16_t*)(ws + WS_WQ + (size_t)ll * 8 * MiB);
                CONV_TASK(a.in[7] + (size_t)ll * D * D, D, D, 0, D, wq, 0, 0, norm_g + (size_t)(ll * 8 + 4) * D, 0.0625f);
                CONV_TASK(a.in[8] + (size_t)ll * D * 2 * D, 2 * D, D, 0, 2 * D, wq + (size_t)D * D, 0, 0, a.in[3] + (size_t)ll * D, 1.0f);
                CONV_TASK(a.in[9] + (size_t)ll * D * D, D, D, 0, D, wq + (size_t)3 * D * D, 0, 0, (const float*)nullptr, 1.0f);
            }
            CONV_TASK(a.in[10], 1536, D, 512, 512, (bf16_t*)(ws + WS_WINVG), 1, 0, norm_g + 2 * D, 1.0f);
            CONV_TASK(a.in[10], 1536, D, 1024, 512, (bf16_t*)(ws + WS_WINVG), 1, 128, norm_g + 2 * D, 1.0f);
            CONV_TASK(a.in[16], D, D, 0, D, (bf16_t*)(ws + WS_WOUTEV), 0, 0, (const float*)nullptr, 1.0f);
            CONV_TASK(a.in[17], 3 * D, D, 0, D, (bf16_t*)(ws + WS_WINB), 0, 0, norm_g + (8 + 2) * D, 1.0f);
            CONV_TASK(a.in[17], 3 * D, D, D, D, (bf16_t*)(ws + WS_WINCV), 1, 0, norm_g + (8 + 2) * D, 1.0f);
            CONV_TASK(a.in[17], 3 * D, D, 2 * D, D, (bf16_t*)(ws + WS_WINCV), 1, 128, norm_g + (8 + 2) * D, 1.0f);
            CONV_TASK(a.in[19], D, D, 0, D, (bf16_t*)(ws + WS_WOUTOD), 0, 0, (const float*)nullptr, 1.0f);
#undef CONV_TASK
        } else {
            l = (ph - 1) / 14; k = (ph - 1) % 14;
            const float* gl = norm_g + (size_t)l * 8 * D;
            if (k == 2 || k == 6 || k == 10 || k == 13) {
                const float* xin = (l == 0 && k == 2) ? a.in[0] : a.out;
                const int gi = (k == 2) ? 1 : (k == 6) ? 3 : (k == 10) ? 5 : 7;
                resid_phase(xin, a.out, XB, SSH, SSX, gl + gi * D, (k == 2 || k == 13) ? 0.5f : 1.0f, gw, NGW, lane);
                if (k == 2 && l == 0) fold_phase(a.in[10], GM, norm_g + 2 * D, WINF, (float*)lds, G, bid, tid);
            } else if (k == 8) {
                attn_phase(QB, (const bf16_t*)(ws + WS_KV + (size_t)l * 8 * MiB), (const bf16_t*)(ws + WS_KV + (size_t)l * 8 * MiB + 4 * MiB), OB, G, bid, wave, lane);
            } else if (k == 4) {
                if (l == 0) { nj = 1; convln_phase(CGLU, YCAT, a.in[12], a.in[13], a.in[14], a.in[15], (float*)lds, G / 2, G - G / 2, bid, tid); }
                else conv3_phase(CV, BG, a.in[18], gw, NGW, lane);
            } else if (k == 0) nj = (l == 0) ? 5 : 1;
            else if (k == 3) nj = 2;
            else nj = 1;
        }
        for (int j = 0; j < nj; ++j) {
            pg8::Gemm g; pg8::EpiG E; int rot = 0;
            g.a_mod = 1 << 20; g.M = T; g.N = D; g.K = D; g.A = XB; g.Bt = XB;
            E.mode = 0; E.act = 0; E.O = XB; E.ldc = D; E.ss = nullptr; E.ssout = SSH; E.cdiv = 1 << 20; E.cbatch = 0; E.rdiv = 1 << 20; E.rsplit = 0;
            const int fj = (k >= 11) ? 1 : 0;
            bf16_t* wgu = (bf16_t*)(ws + WS_W + (size_t)(l * 2 + fj) * (16 * MiB + MiB / 2));
            bf16_t* wq = (bf16_t*)(ws + WS_WQ + (size_t)l * 8 * MiB);
            if (k == 0 || k == 11) {
                if (j == 0) { g.A = XB; g.Bt = wgu; g.N = 2 * FF; E.mode = 1; E.act = 0; E.O = HB; E.ldc = FF; E.ss = SSX; }
                else { const int jj = j - 1, ll = jj >> 1; bf16_t* wkv = (bf16_t*)(ws + WS_WQ + (size_t)ll * 8 * MiB) + (size_t)D * D;
                    bf16_t* kb = (bf16_t*)(ws + WS_KV + (size_t)ll * 8 * MiB);
                    rot = 128 + 32 * jj; E.ss = SSM;
                    if ((jj & 1) == 0) { g.A = MEMB; g.Bt = wkv; g.M = MEMT; g.N = D; E.mode = 0; E.O = kb; E.ldc = D; }
                    else { g.A = wkv + (size_t)D * D; g.Bt = MEMB; g.M = D; g.N = MEMT; E.mode = 3; E.O = kb + 2 * MiB; E.ldc = MEMT; } }
            } else if (k == 1 || k == 12) { g.A = HB; g.Bt = wgu + (size_t)5632 * 1024; g.K = FF; E.mode = 2; E.O = XB; }
            else if (k == 3) {
                if (l == 0) {
                    if (j == 0) { g.A = WINF; g.Bt = XB; g.M = D; g.N = T; E.mode = 3; E.O = PT; E.ldc = 4096; E.ss = SSX; E.cdiv = 8; E.cbatch = 512 * 4096; E.rdiv = 2; E.rsplit = 2048; }
                    else { g.Bt = (bf16_t*)(ws + WS_WINVG); E.mode = 1; E.act = 1; E.O = CGLU; E.ldc = 512; E.ss = SSX; }
                } else {
                    if (j == 0) { g.Bt = (bf16_t*)(ws + WS_WINCV); g.N = 2 * D; E.mode = 1; E.act = 2; E.O = CV; E.ldc = D; E.ss = SSX; }
                    else { g.Bt = (bf16_t*)(ws + WS_WINB); E.mode = 0; E.O = BG; E.ss = SSX; }
                }
            } else if (k == 4) { g.A = CMAT; g.Bt = PT; g.N = 512; g.K = 4096; g.a_mod = 8; E.mode = 0; E.O = YCAT; }
            else if (k == 5) { g.A = (l == 0) ? YCAT : BG; g.Bt = (bf16_t*)(ws + ((l == 0) ? WS_WOUTEV : WS_WOUTOD)); E.mode = 2; E.O = XB; }
            else if (k == 7) { g.Bt = wq; E.mode = 0; E.O = QB; E.ss = SSX; }
            else { g.A = OB; g.Bt = wq + (size_t)3 * D * D; E.mode = 2; E.O = XB; }
            pg8::StaticOrder S; S.init(g.M, g.N, G, (bid + G - rot) % G);
            pg8::gemm_phase<pg8::EpiG, pg8::StaticOrder, true, true>((PG8_LAS unsigned char*)lds, g, S, E);
        }
        if (ph + 1 < a.ph_hi) grid.sync();
    }
}

extern "C" void kernel_launch(void* const* d_in, const int* in_sizes, int n_in, void* d_out, int out_size, void* d_ws, size_t ws_size, hipStream_t stream) {
    static int grid = 0;
    if (grid == 0) {
        if (n_in != 20 || out_size != T * D || ws_size < WS_END) { fprintf(stderr, "kernel_launch: unexpected shapes n_in %d out %d ws %zu\n", n_in, out_size, ws_size); grid = -1; return; }
        int dev = 0, cus = 0, per_cu = 0;
        hipGetDevice(&dev);
        hipDeviceGetAttribute(&cus, hipDeviceAttributeMultiprocessorCount, dev);
        if (hipFuncSetAttribute((const void*)mk_fwd, hipFuncAttributeMaxDynamicSharedMemorySize, LDS_BYTES) != hipSuccess) { fprintf(stderr, "kernel_launch: hipFuncSetAttribute failed\n"); grid = -1; return; }
        if (hipOccupancyMaxActiveBlocksPerMultiprocessor(&per_cu, (const void*)mk_fwd, NTHR, LDS_BYTES) != hipSuccess || per_cu < 1) { fprintf(stderr, "kernel_launch: occupancy query gave %d\n", per_cu); per_cu = 1; }
        (void)hipGetLastError();
        grid = cus;
    }
    if (grid < 0) return;
    Args a{};
    for (int i = 0; i < 20; ++i) a.in[i] = (const float*)d_in[i];
    a.out = (float*)d_out; a.ws = (unsigned char*)d_ws;
#if MK_PER_PHASE
    for (int p = 0; p < NPHASE; ++p) { a.ph_lo = p; a.ph_hi = p + 1; hipLaunchKernelGGL(mk_fwd, dim3(grid), dim3(NTHR), LDS_BYTES, stream, a); }
#else
    a.ph_lo = 0; a.ph_hi = NPHASE;
    void* args[] = {&a};
    hipError_t e = hipLaunchCooperativeKernel((const void*)mk_fwd, dim3(grid), dim3(NTHR), args, LDS_BYTES, stream);
    if (e != hipSuccess) fprintf(stderr, "cooperative launch failed: %s (grid %d)\n", hipGetErrorString(e), grid);
#endif
}
```

```cpp
#include <hip/hip_runtime.h>
#include <hip/hip_cooperative_groups.h>
#include <cstdio>
#include <cstdint>
namespace cg = cooperative_groups;
namespace pg8 {
#define PG8_LAS __attribute__((address_space(3)))
typedef unsigned short bf16_t;
typedef short bf16x8 __attribute__((ext_vector_type(8)));
typedef float f32x4 __attribute__((ext_vector_type(4)));
typedef unsigned u32x4 __attribute__((ext_vector_type(4)));
constexpr int BM = 256, BK = 64, HALF = 128, HTB = HALF * BK * 2  , STAGE_BYTES = 8 * HTB, NXCD = 8, WGM = 8;

__host__ __device__ __forceinline__ int lds_byte(int r, int c) { const int st = (r >> 4) * 2 + (c >> 5), rr = r & 15, cc = c & 31, ob = rr * 64 + cc * 2; return st * 1024 + (ob ^ (((ob >> 9) & 1) << 5)); }
__host__ __device__ __forceinline__ void stage_rc(int b, int& R, int& C) { const int st = b / 1024, sb = b % 1024, swz = sb ^ (((sb >> 9) & 1) << 5); R = (st >> 1) * 16 + swz / 64; C = (st & 1) * 32 + (swz % 64) / 2; }
__host__ __device__ __forceinline__ int perm32(int rho) { const int n = rho >> 4, i = rho & 15; return 8 * (i >> 2) + 4 * n + (i & 3); }

struct Unit { int pm, pn; };
struct Gemm { const bf16_t* A; const bf16_t* Bt; int M, N, K, a_mod; };

struct StaticOrder {
    int nM, nN, nwg, G, c;
    __host__ __device__ void init(int M, int N, int G_, int c_) { nM = M / BM; nN = N / BM; nwg = nM * nN; G = G_; c = c_; }
    __host__ __device__ bool next(int i, Unit& u) const {
        const long L = (long)i * G + c; if (L >= nwg) return false;
        int wgid = (int)L; { const int q = nwg / NXCD, r = nwg % NXCD, xcd = wgid % NXCD, off = wgid / NXCD; wgid = (xcd < r ? xcd * (q + 1) : r * (q + 1) + (xcd - r) * q) + off; }
        const int nig = WGM * nN, gid = wgid / nig, fm = gid * WGM, gsz = (nM - fm) < WGM ? (nM - fm) : WGM;
        u.pm = fm + ((wgid % nig) % gsz); u.pn = (wgid % nig) / gsz; return true;
    }
    __device__ __forceinline__ void a_ready(const Unit&) const {}
    __device__ __forceinline__ void done(const Unit&) const {}
};

__device__ __forceinline__ unsigned cvt_pk_bf16(float lo, float hi) { unsigned r; asm volatile("v_cvt_pk_bf16_f32 %0, %1, %2" : "=v"(r) : "v"(lo), "v"(hi)); return r; }
typedef float f32x2 __attribute__((ext_vector_type(2)));
typedef float f32x2 __attribute__((ext_vector_type(2)));
constexpr float NORM_EPS = 1e-6f;
__device__ __forceinline__ float rstd_of(float ss) { return __builtin_amdgcn_rsqf(ss * (1.0f / 1024.0f) + NORM_EPS); }
__device__ __forceinline__ float fast_sigmoid(float v) { return __builtin_amdgcn_rcpf(1.0f + __expf(-v)); }
__device__ __forceinline__ const char* aptr(const Gemm& g, const Unit& u) { return (const char*)g.A + (size_t)(u.pm % g.a_mod) * ((size_t)BM * g.K * 2); }
__device__ __forceinline__ const char* bptr(const Gemm& g, const Unit& u) { return (const char*)g.Bt + (size_t)((u.pm / g.a_mod) * (g.N / BM) + u.pn) * ((size_t)BM * g.K * 2); }

struct EpiG {
    static constexpr bool PERM = true, AFTER_DRAIN = false;
    int mode, act; bf16_t* O; int ldc; const float* ss; float* ssout; int cdiv; long cbatch; int rdiv; long rsplit;
    __device__ __forceinline__ void operator()(const f32x4 (&acc)[2][2][4][2], const Unit& u, int wr, int wc, int fr, int fq) const {
        const int row0 = u.pm * BM + wr * 64 + fr;
        if (mode == 0 || mode == 2) {
            const int col0 = u.pn * BM + wc * 32 + 8 * fq;
#pragma unroll
            for (int ai = 0; ai < 2; ++ai)
#pragma unroll
                for (int m = 0; m < 4; ++m) {
                    const int row = row0 + ai * HALF + m * 16;
                    const float rs = ss ? rstd_of(ss[row]) : 1.0f;
                    float sq = 0.f;
                    bf16_t* rowp = O + (size_t)row * ldc + col0;
#pragma unroll
                    for (int bj = 0; bj < 2; ++bj) {
                        f32x4 v0 = acc[ai][bj][m][0] * rs, v1 = acc[ai][bj][m][1] * rs;
                        sq += (v0[0] * v0[0] + v0[1] * v0[1]) + (v0[2] * v0[2] + v0[3] * v0[3]) + (v1[0] * v1[0] + v1[1] * v1[1]) + (v1[2] * v1[2] + v1[3] * v1[3]);
                        u32x4 w; w.x = cvt_pk_bf16(v0[0], v0[1]); w.y = cvt_pk_bf16(v0[2], v0[3]); w.z = cvt_pk_bf16(v1[0], v1[1]); w.w = cvt_pk_bf16(v1[2], v1[3]);
                        *(u32x4*)(rowp + bj * HALF) = w;
                    }
                    if (mode == 2) { sq += __shfl_xor(sq, 16); sq += __shfl_xor(sq, 32); if (fq == 0) ssout[(size_t)row * 16 + u.pn * 4 + wc] = sq; }
                }
        } else if (mode == 1) {
            const int col0 = u.pn * HALF + wc * 32 + 8 * fq;
#pragma unroll
            for (int ai = 0; ai < 2; ++ai)
#pragma unroll
                for (int m = 0; m < 4; ++m) {
                    const int row = row0 + ai * HALF + m * 16;
                    const float rs = ss ? rstd_of(ss[row]) : 1.0f;
                    float o[8];
#pragma unroll
                    for (int n = 0; n < 2; ++n)
#pragma unroll
                        for (int j = 0; j < 4; ++j) {
                            const float a = acc[ai][0][m][n][j] * rs, b = acc[ai][1][m][n][j] * rs;
                            float r;
                            if (act == 0) r = a * fast_sigmoid(a) * b; else if (act == 1) r = a * fast_sigmoid(b); else r = a * b;
                            o[n * 4 + j] = r;
                        }
                    u32x4 w; w.x = cvt_pk_bf16(o[0], o[1]); w.y = cvt_pk_bf16(o[2], o[3]); w.z = cvt_pk_bf16(o[4], o[5]); w.w = cvt_pk_bf16(o[6], o[7]);
                    *(u32x4*)(O + (size_t)row * ldc + col0) = w;
                }
        } else {
            bf16_t* base = O + (size_t)(u.pn / cdiv) * cbatch + (size_t)(u.pn % cdiv) * BM + (size_t)(u.pm / rdiv) * rsplit + (size_t)(u.pm % rdiv) * BM * ldc;
            const int tok0 = u.pn * BM + wc * 32 + 8 * fq;
            f32x4 rsv[2][2];
#pragma unroll
            for (int bj = 0; bj < 2; ++bj)
#pragma unroll
                for (int n = 0; n < 2; ++n) { const f32x4 s4 = *(const f32x4*)(ss + tok0 + bj * HALF + 4 * n);
                    rsv[bj][n] = (f32x4){rstd_of(s4[0]), rstd_of(s4[1]), rstd_of(s4[2]), rstd_of(s4[3])}; }
#pragma unroll
            for (int ai = 0; ai < 2; ++ai)
#pragma unroll
                for (int m = 0; m < 4; ++m) {
                    const int rl = wr * 64 + fr + ai * HALF + m * 16;
                    bf16_t* rowp = base + (size_t)rl * ldc + wc * 32 + 8 * fq;
#pragma unroll
                    for (int bj = 0; bj < 2; ++bj) {
                        const f32x4 v0 = acc[ai][bj][m][0] * rsv[bj][0], v1 = acc[ai][bj][m][1] * rsv[bj][1];
                        u32x4 w; w.x = cvt_pk_bf16(v0[0], v0[1]); w.y = cvt_pk_bf16(v0[2], v0[3]); w.z = cvt_pk_bf16(v1[0], v1[1]); w.w = cvt_pk_bf16(v1[2], v1[3]);
                        *(u32x4*)(rowp + bj * HALF) = w;
                    }
                }
        }
    }
};
template <class Epi, class Sched, bool ALIGN_EPI = false, bool SP2 = false>
__device__ __forceinline__ void gemm_phase(PG8_LAS unsigned char* lds, const Gemm g, const Sched& S, const Epi& E) {
    int tid = threadIdx.x; asm volatile("" : "+v"(tid)); const int wid = __builtin_amdgcn_readfirstlane(tid >> 6), lane = tid & 63, wr = wid >> 2, wc = wid & 3, fr = lane & 15, fq = lane >> 4;
    const int K = g.K, nt = K / BK;
    unsigned voffA[2], voffB[2];
#pragma unroll
    for (int i = 0; i < 2; ++i) { int R, C; stage_rc(tid * 16 + i * 8192, R, C); const int Rb = Epi::PERM ? ((R & ~31) + perm32(R & 31)) : R;
        voffA[i] = (unsigned)(R * K + C) * 2u; voffB[i] = (unsigned)(Rb * K + C) * 2u; }
    const size_t kstep = (size_t)(BK * 2);
    const size_t hstep = (size_t)HALF * K * 2;
    const unsigned ldsw = (unsigned)wid * 1024u;
    const int aoff = lds_byte(wr * 64 + fr, fq * 8), boff = lds_byte(wc * 32 + fr, fq * 8);
#define PG8_SA(b, h) (((b) * 2 + (h)) * HTB)
#define PG8_SB(b, h) ((4 + (b) * 2 + (h)) * HTB)
#define PG8_STAGE(bufoff, gbase, voff) do { _Pragma("unroll") for (int _i = 0; _i < 2; ++_i) \
        __builtin_amdgcn_global_load_lds((const unsigned*)((const char*)(gbase) + (voff)[_i]), (PG8_LAS unsigned*)(lds + (bufoff) + ldsw + _i * 8192), 16, 0, 0); } while (0)
#define PG8_LDA(dst, b, h) do { _Pragma("unroll") for (int m = 0; m < 4; ++m) _Pragma("unroll") for (int k = 0; k < 2; ++k) dst[m][k] = *(const PG8_LAS bf16x8*)(lds + PG8_SA(b, h) + aoff + m * 2048 + k * 1024); } while (0)
#define PG8_LDB(dst, b, h) do { _Pragma("unroll") for (int n = 0; n < 2; ++n) _Pragma("unroll") for (int k = 0; k < 2; ++k) dst[n][k] = *(const PG8_LAS bf16x8*)(lds + PG8_SB(b, h) + boff + n * 2048 + k * 1024); } while (0)
#define PG8_MMA(ai, bj, At, Bt) do { __builtin_amdgcn_s_setprio(1); _Pragma("unroll") for (int m = 0; m < 4; ++m) _Pragma("unroll") for (int n = 0; n < 2; ++n) _Pragma("unroll") for (int k = 0; k < 2; ++k) \
        acc[ai][bj][m][n] = __builtin_amdgcn_mfma_f32_16x16x32_bf16(Bt[n][k], At[m][k], acc[ai][bj][m][n], 0, 0, 0); __builtin_amdgcn_s_setprio(0); } while (0)
#define PG8_WAIT_V(n) asm volatile("s_waitcnt vmcnt(" #n ")" ::: "memory")
#define PG8_WAIT_L(n) asm volatile("s_waitcnt lgkmcnt(" #n ")" ::: "memory")
#define PG8_BAR __builtin_amdgcn_s_barrier()
#define PG8_SCHED __builtin_amdgcn_sched_barrier(0)
    Unit cur, nxt; int ui = 0;
    if (!S.next(0, cur)) return;
    f32x4 acc[2][2][4][2];
#pragma unroll
    for (int a = 0; a < 2; ++a)
#pragma unroll
        for (int b = 0; b < 2; ++b)
#pragma unroll
            for (int m = 0; m < 4; ++m)
#pragma unroll
                for (int n = 0; n < 2; ++n) acc[a][b][m][n] = (f32x4){0.f, 0.f, 0.f, 0.f};
    bf16x8 At[4][2], B0[2][2], B1[2][2];
    const char* cA = aptr(g, cur); const char* cB = bptr(g, cur);
    S.a_ready(cur);
    if constexpr (SP2) {
        PG8_STAGE(PG8_SB(0, 0), cB, voffB); PG8_STAGE(PG8_SB(0, 1), cB + hstep, voffB); PG8_STAGE(PG8_SA(0, 0), cA, voffA); PG8_STAGE(PG8_SA(0, 1), cA + hstep, voffA);
        if (wr == 1) PG8_BAR;
        PG8_WAIT_V(2); PG8_BAR;
        PG8_STAGE(PG8_SB(1, 0), cB + kstep, voffB); PG8_STAGE(PG8_SA(1, 0), cA + kstep, voffA); PG8_STAGE(PG8_SB(1, 1), cB + hstep + kstep, voffB);
        PG8_WAIT_V(6); PG8_BAR;
    } else {
        PG8_STAGE(PG8_SB(0, 0), cB, voffB); PG8_STAGE(PG8_SA(0, 0), cA, voffA); PG8_STAGE(PG8_SB(0, 1), cB + hstep, voffB); PG8_STAGE(PG8_SA(0, 1), cA + hstep, voffA);
        if (wr == 1) PG8_BAR;
        PG8_WAIT_V(4); PG8_BAR;
        PG8_STAGE(PG8_SB(1, 0), cB + kstep, voffB); PG8_STAGE(PG8_SA(1, 0), cA + kstep, voffA); PG8_STAGE(PG8_SB(1, 1), cB + hstep + kstep, voffB);
        PG8_WAIT_V(6); PG8_BAR;
    }
    for (;;) {
        const bool has_next = S.next(ui + 1, nxt);
        const char* nA = has_next ? aptr(g, nxt) : cA; const char* nB = has_next ? bptr(g, nxt) : cB;
        for (int t = 0; t < nt; t += 2) {
            const bool last = (t == nt - 2);
            const char* a1 = cA + (size_t)(t + 1) * kstep;
            const char* a2 = last ? nA : cA + (size_t)(t + 2) * kstep; const char* b2 = last ? nB : cB + (size_t)(t + 2) * kstep;
            const char* a3 = a2 + kstep; const char* b3 = b2 + kstep;
            if (last && has_next) S.a_ready(nxt);
            if constexpr (SP2) {
            PG8_LDB(B0, 0, 0); PG8_LDB(B1, 0, 1); PG8_SCHED; PG8_LDA(At, 0, 0); PG8_STAGE(PG8_SA(1, 1), a1 + hstep, voffA);
            PG8_WAIT_V(8); PG8_WAIT_L(0); PG8_BAR; PG8_MMA(0, 0, At, B0); PG8_MMA(0, 1, At, B1); PG8_BAR; PG8_SCHED;
            PG8_LDA(At, 0, 1); PG8_STAGE(PG8_SB(0, 0), b2, voffB); PG8_STAGE(PG8_SB(0, 1), b2 + hstep, voffB); PG8_STAGE(PG8_SA(0, 0), a2, voffA);
            PG8_WAIT_V(8); PG8_WAIT_L(0); PG8_BAR; PG8_MMA(1, 0, At, B0); PG8_MMA(1, 1, At, B1); PG8_BAR; PG8_SCHED;
            PG8_LDB(B0, 1, 0); PG8_LDB(B1, 1, 1); PG8_SCHED; PG8_LDA(At, 1, 0); PG8_STAGE(PG8_SA(0, 1), a2 + hstep, voffA);
            PG8_WAIT_V(8); PG8_WAIT_L(0); PG8_BAR; PG8_MMA(0, 0, At, B0); PG8_MMA(0, 1, At, B1); PG8_BAR; PG8_SCHED;
            PG8_LDA(At, 1, 1); PG8_STAGE(PG8_SB(1, 0), b3, voffB); PG8_STAGE(PG8_SB(1, 1), b3 + hstep, voffB); PG8_STAGE(PG8_SA(1, 0), a3, voffA);
            PG8_WAIT_V(8); PG8_WAIT_L(0); PG8_BAR; PG8_MMA(1, 0, At, B0); PG8_MMA(1, 1, At, B1); PG8_BAR; PG8_SCHED;
            } else {
            PG8_LDB(B0, 0, 0); PG8_SCHED; PG8_LDA(At, 0, 0); PG8_STAGE(PG8_SA(1, 1), a1 + hstep, voffA);
            PG8_WAIT_L(8); PG8_BAR; PG8_WAIT_L(0); PG8_MMA(0, 0, At, B0); PG8_BAR; PG8_SCHED;
            PG8_LDB(B1, 0, 1); PG8_STAGE(PG8_SB(0, 0), b2, voffB);
            PG8_BAR; PG8_WAIT_L(0); PG8_MMA(0, 1, At, B1); PG8_BAR;
            PG8_LDA(At, 0, 1); PG8_STAGE(PG8_SA(0, 0), a2, voffA);
            PG8_BAR; PG8_WAIT_L(0); PG8_MMA(1, 0, At, B0); PG8_BAR; PG8_SCHED;
            PG8_STAGE(PG8_SB(0, 1), b2 + hstep, voffB);
            PG8_WAIT_V(6); PG8_BAR; PG8_MMA(1, 1, At, B1); PG8_BAR;
            PG8_LDB(B0, 1, 0); PG8_SCHED; PG8_LDA(At, 1, 0); PG8_STAGE(PG8_SA(0, 1), a2 + hstep, voffA);
            PG8_WAIT_L(8); PG8_BAR; PG8_WAIT_L(0); PG8_MMA(0, 0, At, B0); PG8_BAR; PG8_SCHED;
            PG8_LDB(B1, 1, 1); PG8_STAGE(PG8_SB(1, 0), b3, voffB);
            PG8_BAR; PG8_WAIT_L(0); PG8_MMA(0, 1, At, B1); PG8_BAR;
            PG8_LDA(At, 1, 1); PG8_STAGE(PG8_SA(1, 0), a3, voffA);
            PG8_BAR; PG8_WAIT_L(0); PG8_MMA(1, 0, At, B0); PG8_BAR; PG8_SCHED;
            PG8_STAGE(PG8_SB(1, 1), b3 + hstep, voffB);
            PG8_WAIT_V(6); PG8_BAR; PG8_MMA(1, 1, At, B1); PG8_BAR;
            }
        }
        if constexpr (ALIGN_EPI) { if (wr == 0) PG8_BAR; }
        if constexpr (!Epi::AFTER_DRAIN) { E(acc, cur, wr, wc, fr, fq); S.done(cur); }
        if (!has_next) break;
#pragma unroll
        for (int a = 0; a < 2; ++a)
#pragma unroll
            for (int b = 0; b < 2; ++b)
#pragma unroll
                for (int m = 0; m < 4; ++m)
#pragma unroll
                    for (int n = 0; n < 2; ++n) acc[a][b][m][n] = (f32x4){0.f, 0.f, 0.f, 0.f};
        cur = nxt; cA = nA; cB = nB; ++ui;
        if constexpr (ALIGN_EPI) { if (wr == 1) PG8_BAR; }
    }
    PG8_WAIT_V(0);
    if constexpr (!ALIGN_EPI) { if (wr == 0) PG8_BAR; }
    PG8_BAR;
    if constexpr (Epi::AFTER_DRAIN) { E.fused(acc, cur, wr, wc, fr, fq, lds, wid, lane); S.done(cur); }
#undef PG8_SA
#undef PG8_SB
#undef PG8_STAGE
#undef PG8_LDA
#undef PG8_LDB
#undef PG8_MMA
#undef PG8_WAIT_V
#undef PG8_WAIT_L
#undef PG8_BAR
#undef PG8_SCHED
}
}

#ifndef MK_PER_PHASE
#define MK_PER_PHASE 0
#endif
using pg8::bf16_t; using pg8::bf16x8; using pg8::f32x4; using pg8::u32x4;
typedef short s16x4 __attribute__((ext_vector_type(4)));
typedef unsigned u32x2 __attribute__((ext_vector_type(2)));
#define LAS __attribute__((address_space(3)))
constexpr int NWAVES = 8, NTHR = 512;
constexpr int T = 16384, D = 1024, FF = 2816, SEQ = 2048, NB = 8, MEMT = 2048;
constexpr size_t MiB = 1u << 20;
constexpr size_t WS_SSX = 0, WS_SSM = 131072, WS_G = 262144, WS_SSH = 1u << 20;
constexpr size_t WS_MEMB = 2 * MiB, WS_KV = 6 * MiB, WS_W = 22 * MiB;
constexpr size_t WS_WQ = 88 * MiB, WS_WINF = 104 * MiB, WS_WINVG = 106 * MiB, WS_WOUTEV = 108 * MiB, WS_WINCV = 110 * MiB, WS_WINB = 114 * MiB, WS_WOUTOD = 116 * MiB, WS_CMAT = 118 * MiB;
constexpr size_t WS_XB = 134 * MiB, WS_AR = 166 * MiB, WS_END = 254 * MiB;
constexpr int LDS_BYTES = 147456, TAB_OFF = 131072, MISC_OFF = TAB_OFF + 8192;
constexpr size_t WS_BAR = 768 * 1024;
constexpr int NPHASE = 29;

struct Args { const float* in[20]; float* out; unsigned char* ws; int ph_lo, ph_hi; };

__device__ __forceinline__ float wave_sum(float v) {
#pragma unroll
    for (int o = 1; o < 64; o <<= 1) v += __shfl_xor(v, o);
    return v;
}
__device__ __forceinline__ unsigned pk2(float lo, float hi) { return pg8::cvt_pk_bf16(lo, hi); }
__device__ __forceinline__ float bf_lo(unsigned w) { return __uint_as_float(w << 16); }
__device__ __forceinline__ float bf_hi(unsigned w) { return __uint_as_float(w & 0xffff0000u); }

__device__ __forceinline__ void tr_item(const float* W, int ld, int K, int nsrc, bf16_t* WT, int drow, const float* gain, float scale, float* scr, int kb, int lane) {
    const int k0 = 64 * kb;
#pragma unroll 8
    for (int i = 0; i < 32; ++i) { const int kk = 2 * i + (lane >> 5); const float gsc = gain ? gain[k0 + kk] * scale : scale;
        scr[kk * 33 + (lane & 31)] = W[(size_t)(k0 + kk) * ld + nsrc + (lane & 31)] * gsc; }
    asm volatile("s_waitcnt lgkmcnt(0)" ::: "memory");
    const int c = lane & 7;
#pragma unroll
    for (int j = 0; j < 4; ++j) { const int n = (lane >> 3) + 8 * j; const float* s = scr + (8 * c) * 33 + n;
        u32x4 o; o.x = pk2(s[0 * 33], s[1 * 33]); o.y = pk2(s[2 * 33], s[3 * 33]); o.z = pk2(s[4 * 33], s[5 * 33]); o.w = pk2(s[6 * 33], s[7 * 33]);
        *(u32x4*)(WT + (size_t)(drow + n) * K + k0 + 8 * c) = o; }
    asm volatile("s_waitcnt lgkmcnt(0)" ::: "memory");
}

__device__ __forceinline__ void row_to_bf16_ss(const float* xrow, bf16_t* orow, float* ssp, int lane) {
    float s = 0.f;
#pragma unroll
    for (int j = 0; j < 4; ++j) { const f32x4 v = *(const f32x4*)(xrow + 256 * j + 4 * lane);
        s += (v[0] * v[0] + v[1] * v[1]) + (v[2] * v[2] + v[3] * v[3]);
        u32x2 o; o.x = pk2(v[0], v[1]); o.y = pk2(v[2], v[3]); *(u32x2*)(orow + 256 * j + 4 * lane) = o; }
    s = wave_sum(s);
    if (lane == 0) *ssp = s;
}

__device__ __forceinline__ void resid_phase(const float* xin, float* xout, bf16_t* hxb, float* SSH, float* SSX, const float* g, float alpha, int gw, int NGW, int lane) {
    for (int row = gw; row < T; row += NGW) {
        const float rs = pg8::rstd_of(wave_sum(lane < 16 ? SSH[(size_t)row * 16 + lane] : 0.f)) * alpha;
        float s = 0.f;
#pragma unroll
        for (int j = 0; j < 4; ++j) {
            const size_t off = (size_t)row * D + 256 * j + 4 * lane;
            const u32x2 hw = *(const u32x2*)(hxb + off);
            const f32x4 xv = *(const f32x4*)(xin + off);
            const f32x4 gv = *(const f32x4*)(g + 256 * j + 4 * lane);
            f32x4 o;
            o[0] = xv[0] + bf_lo(hw.x) * rs * gv[0]; o[1] = xv[1] + bf_hi(hw.x) * rs * gv[1];
            o[2] = xv[2] + bf_lo(hw.y) * rs * gv[2]; o[3] = xv[3] + bf_hi(hw.y) * rs * gv[3];
            s += (o[0] * o[0] + o[1] * o[1]) + (o[2] * o[2] + o[3] * o[3]);
            *(f32x4*)(xout + off) = o;
            u32x2 ob; ob.x = pk2(o[0], o[1]); ob.y = pk2(o[2], o[3]); *(u32x2*)(hxb + off) = ob;
        }
        s = wave_sum(s);
        if (lane == 0) SSX[row] = s;
    }
}

__device__ __forceinline__ void attn_phase(const bf16_t* Q, const bf16_t* Kb, const bf16_t* Vt, bf16_t* O, int G, int bid, int wave, int lane) {
    const int fr = lane & 15, fq = lane >> 4;
    for (int unit = bid; unit < 256; unit += G) {
        const int b = unit >> 5, h = (unit >> 3) & 3, qb = unit & 7;
        const int row0 = b * SEQ + qb * 256 + wave * 32;
        f32x4 S[2][16];
#pragma unroll
        for (int qt = 0; qt < 2; ++qt)
#pragma unroll
            for (int mt = 0; mt < 16; ++mt) S[qt][mt] = (f32x4){0.f, 0.f, 0.f, 0.f};
        const bf16_t* qp = Q + (size_t)(row0 + fr) * D + h * 256 + fq * 8;
        const bf16_t* kp = Kb + (size_t)(b * 256 + fr) * D + h * 256 + fq * 8;
#pragma unroll 1
        for (int ks = 0; ks < 8; ++ks) {
            const bf16x8 q0 = *(const bf16x8*)(qp + ks * 32), q1 = *(const bf16x8*)(qp + 16 * D + ks * 32);
#pragma unroll
            for (int mt = 0; mt < 16; ++mt) {
                const bf16x8 kf = *(const bf16x8*)(kp + (size_t)mt * 16 * D + ks * 32);
                S[0][mt] = __builtin_amdgcn_mfma_f32_16x16x32_bf16(kf, q0, S[0][mt], 0, 0, 0);
                S[1][mt] = __builtin_amdgcn_mfma_f32_16x16x32_bf16(kf, q1, S[1][mt], 0, 0, 0);
            }
        }
        float inv[2]; bf16x8 pf[2][8];
#pragma unroll
        for (int qt = 0; qt < 2; ++qt) {
            float mx = -3.0e38f;
#pragma unroll
            for (int mt = 0; mt < 16; ++mt)
#pragma unroll
                for (int r = 0; r < 4; ++r) mx = fmaxf(mx, S[qt][mt][r]);
            mx = fmaxf(mx, __shfl_xor(mx, 16)); mx = fmaxf(mx, __shfl_xor(mx, 32));
            float sum = 0.f;
#pragma unroll
            for (int mt = 0; mt < 16; ++mt)
#pragma unroll
                for (int r = 0; r < 4; ++r) { const float e = __expf(S[qt][mt][r] - mx); S[qt][mt][r] = e; sum += e; }
            sum += __shfl_xor(sum, 16); sum += __shfl_xor(sum, 32);
            inv[qt] = 1.0f / sum;
#pragma unroll
            for (int kc = 0; kc < 8; ++kc) {
                u32x4 w; w.x = pk2(S[qt][2 * kc][0], S[qt][2 * kc][1]); w.y = pk2(S[qt][2 * kc][2], S[qt][2 * kc][3]);
                w.z = pk2(S[qt][2 * kc + 1][0], S[qt][2 * kc + 1][1]); w.w = pk2(S[qt][2 * kc + 1][2], S[qt][2 * kc + 1][3]);
                pf[qt][kc] = __builtin_bit_cast(bf16x8, w);
            }
        }
        const bf16_t* vp = Vt + (size_t)(h * 256 + fr) * MEMT + b * 256 + 4 * fq;
        bf16_t* op = O + (size_t)(row0 + fr) * D + h * 256 + 4 * fq;
#pragma unroll 2
        for (int dt = 0; dt < 16; ++dt) {
            f32x4 o0 = (f32x4){0.f, 0.f, 0.f, 0.f}, o1 = (f32x4){0.f, 0.f, 0.f, 0.f};
#pragma unroll
            for (int kc = 0; kc < 8; ++kc) {
                const u32x2 lo = *(const u32x2*)(vp + (size_t)dt * 16 * MEMT + kc * 32), hi = *(const u32x2*)(vp + (size_t)dt * 16 * MEMT + kc * 32 + 16);
                u32x4 w; w.x = lo.x; w.y = lo.y; w.z = hi.x; w.w = hi.y;
                const bf16x8 vf = __builtin_bit_cast(bf16x8, w);
                o0 = __builtin_amdgcn_mfma_f32_16x16x32_bf16(vf, pf[0][kc], o0, 0, 0, 0);
                o1 = __builtin_amdgcn_mfma_f32_16x16x32_bf16(vf, pf[1][kc], o1, 0, 0, 0);
            }
            u32x2 w0, w1; w0.x = pk2(o0[0] * inv[0], o0[1] * inv[0]); w0.y = pk2(o0[2] * inv[0], o0[3] * inv[0]);
            w1.x = pk2(o1[0] * inv[1], o1[1] * inv[1]); w1.y = pk2(o1[2] * inv[1], o1[3] * inv[1]);
            *(u32x2*)(op + dt * 16) = w0; *(u32x2*)(op + 16 * D + dt * 16) = w1;
        }
    }
}

__device__ __forceinline__ void convln_phase(const bf16_t* C, bf16_t* Ycat, const float* dww, const float* dwb, const float* gng, const float* gnb, float* lds, int first, int nblk, int bid, int tid) {
    if (bid < first) return;
    const int wave = tid >> 6, lane = tid & 63;
    float* Cin = lds;
    float* Cout = lds + 94 * 128;
    for (int it = bid - first; it < 1024; it += nblk) {
        const int g = it & 3, sc = (it >> 2) & 31, b = it >> 7, s0 = sc * 64;
        for (int ch = tid; ch < 94 * 16; ch += NTHR) {
            const int r = ch >> 4, c8 = (ch & 15) * 8, s = s0 - 15 + r;
            f32x4 a = (f32x4){0.f, 0.f, 0.f, 0.f}, bb = a;
            if (s >= 0 && s < SEQ) { const u32x4 w = *(const u32x4*)(C + (size_t)(b * SEQ + s) * 512 + g * 128 + c8);
                a = (f32x4){bf_lo(w.x), bf_hi(w.x), bf_lo(w.y), bf_hi(w.y)}; bb = (f32x4){bf_lo(w.z), bf_hi(w.z), bf_lo(w.w), bf_hi(w.w)}; }
            *(f32x4*)(Cin + r * 128 + c8) = a; *(f32x4*)(Cin + r * 128 + c8 + 4) = bb;
        }
        __syncthreads();
        {
            const int ch = tid & 127, rg = tid >> 7;
            float w[31];
#pragma unroll
            for (int k = 0; k < 31; ++k) w[k] = dww[k * 512 + g * 128 + ch];
            const float bias = dwb[g * 128 + ch];
            float acc[16];
#pragma unroll
            for (int r = 0; r < 16; ++r) acc[r] = bias;
#pragma unroll
            for (int i = 0; i < 46; ++i) {
                const float v = Cin[(rg * 16 + i) * 128 + ch];
#pragma unroll
                for (int r = 0; r < 16; ++r) { if (i - r >= 0 && i - r < 31) acc[r] += v * w[i - r]; }
            }
#pragma unroll
            for (int r = 0; r < 16; ++r) Cout[(rg * 16 + r) * 128 + ch] = acc[r];
        }
        __syncthreads();
        {
            const float g0 = gng[g * 128 + 2 * lane], g1 = gng[g * 128 + 2 * lane + 1], b0 = gnb[g * 128 + 2 * lane], b1 = gnb[g * 128 + 2 * lane + 1];
#pragma unroll
            for (int rr = 0; rr < 8; ++rr) {
                const int r = wave * 8 + rr;
                const float v0 = Cout[r * 128 + 2 * lane], v1 = Cout[r * 128 + 2 * lane + 1];
                const float mu = wave_sum(v0 + v1) * (1.0f / 128.0f);
                const float d0 = v0 - mu, d1 = v1 - mu;
                const float var = wave_sum(d0 * d0 + d1 * d1) * (1.0f / 128.0f);
                const float rs = __builtin_amdgcn_rsqf(var + 1e-6f);
                float y0 = d0 * rs * g0 + b0, y1 = d1 * rs * g1 + b1;
                y0 = y0 * pg8::fast_sigmoid(y0); y1 = y1 * pg8::fast_sigmoid(y1);
                *(unsigned*)(Ycat + (size_t)(b * SEQ + s0 + r) * D + 512 + g * 128 + 2 * lane) = pk2(y0, y1);
            }
        }
        __syncthreads();
    }
}

__device__ __forceinline__ void conv3_phase(const bf16_t* CV, bf16_t* BG, const float* cw, int gw, int NGW, int lane) {
    for (int row = gw; row < T; row += NGW) {
        const int s = row & (SEQ - 1);
#pragma unroll
        for (int hlf = 0; hlf < 2; ++hlf) {
            const int c0 = hlf * 512 + 8 * lane;
            const size_t off = (size_t)row * D + c0;
            const u32x4 z = (u32x4){0u, 0u, 0u, 0u};
            const u32x4 cm = (s > 0) ? *(const u32x4*)(CV + off - D) : z;
            const u32x4 cc = *(const u32x4*)(CV + off);
            const u32x4 cp = (s < SEQ - 1) ? *(const u32x4*)(CV + off + D) : z;
            const u32x4 bg = *(const u32x4*)(BG + off);
            const f32x4 w0a = *(const f32x4*)(cw + c0), w0b = *(const f32x4*)(cw + c0 + 4);
            const f32x4 w1a = *(const f32x4*)(cw + D + c0), w1b = *(const f32x4*)(cw + D + c0 + 4);
            const f32x4 w2a = *(const f32x4*)(cw + 2 * D + c0), w2b = *(const f32x4*)(cw + 2 * D + c0 + 4);
            u32x4 ow;
#pragma unroll
            for (int j = 0; j < 4; ++j) {
                const float w00 = (j < 2) ? w0a[2 * j] : w0b[2 * j - 4], w01 = (j < 2) ? w0a[2 * j + 1] : w0b[2 * j - 3];
                const float w10 = (j < 2) ? w1a[2 * j] : w1b[2 * j - 4], w11 = (j < 2) ? w1a[2 * j + 1] : w1b[2 * j - 3];
                const float w20 = (j < 2) ? w2a[2 * j] : w2b[2 * j - 4], w21 = (j < 2) ? w2a[2 * j + 1] : w2b[2 * j - 3];
                const float y0 = bf_lo(bg[j]) * (w00 * bf_lo(cm[j]) + w10 * bf_lo(cc[j]) + w20 * bf_lo(cp[j]));
                const float y1 = bf_hi(bg[j]) * (w01 * bf_hi(cm[j]) + w11 * bf_hi(cc[j]) + w21 * bf_hi(cp[j]));
                ow[j] = pk2(y0, y1);
            }
            *(u32x4*)(BG + off) = ow;
        }
    }
}
#define XB_TMO      128
#define XB_XCNT(j)  (256  + 64 * (j))
#define XB_XSUB(j)  (1280 + 64 * (j))
#define XB_XGEN(j)  (2304 + 64 * (j))
#define XB_TOP      3328
#define XB_TOPGEN   3392
#define XCD_BAR_WORDS 3456
#define XB_SPIN_CAP (1u << 18)

__device__ __forceinline__ unsigned xb_ld(unsigned* p)              { return __hip_atomic_load(p, __ATOMIC_RELAXED, __HIP_MEMORY_SCOPE_AGENT); }
__device__ __forceinline__ unsigned xb_add(unsigned* p, unsigned v) { return __hip_atomic_fetch_add(p, v, __ATOMIC_RELAXED, __HIP_MEMORY_SCOPE_AGENT); }
__device__ __forceinline__ unsigned xb_xcc_id() { return (unsigned)__builtin_amdgcn_s_getreg((3 << 11) | 20) & 0xFu; }
#define XB_SPIN(cond, bar) do { unsigned _sp = 0; while (cond) { __builtin_amdgcn_s_sleep(1); \
    if ((++_sp & 255u) == 0u) { if (xb_ld(&(bar)[XB_TMO])) break; if (_sp > XB_SPIN_CAP) { atomicAdd(&(bar)[XB_TMO], 1u); break; } } } } while (0)

struct XcdBarrier {
    unsigned* bar; unsigned x;
    volatile LAS unsigned* st;
};

__device__ __forceinline__ XcdBarrier xcd_barrier_post(unsigned* bar, volatile LAS unsigned* st) {
    XcdBarrier b; b.bar = bar; b.x = xb_xcc_id(); b.st = st;
    if (threadIdx.x == 0) (void)xb_add(&bar[XB_XCNT(b.x)], 1u);
    return b;
}
__device__ __forceinline__ void xcd_barrier_complete(unsigned* bar, unsigned x, unsigned& nloc, unsigned& nx) {
    const unsigned G = gridDim.x * gridDim.y * gridDim.z;
    unsigned sum, cnt, mine, sp = 0u;
    for (;;) {
        sum = 0u; cnt = 0u; mine = 0u;
#pragma unroll
        for (unsigned j = 0; j < 16; ++j) { const unsigned c = xb_ld(&bar[XB_XCNT(j)]); sum += c; cnt += (c > 0u) ? 1u : 0u; mine = (j == x) ? c : mine; }
        if (sum == G) break;
        __builtin_amdgcn_s_sleep(1);
        if ((++sp & 255u) == 0u) { if (xb_ld(&bar[XB_TMO])) break; if (sp > XB_SPIN_CAP) { atomicAdd(&bar[XB_TMO], 1u); break; } }
    }
    nloc = mine > 0u ? mine : 1u; nx = cnt > 0u ? cnt : 1u;
}

__device__ __forceinline__ void xcd_barrier(const XcdBarrier& b) {
    asm volatile("s_waitcnt vmcnt(0)" ::: "memory");
    __syncthreads();
    if (threadIdx.x == 0) {
        unsigned* bar = b.bar;
        __builtin_amdgcn_s_waitcnt(0);
        unsigned nloc = b.st[0], nx = b.st[1];
        if (nloc == 0u) { xcd_barrier_complete(bar, b.x, nloc, nx); b.st[0] = nloc; b.st[1] = nx; }
        const unsigned old = xb_add(&bar[XB_XSUB(b.x)], 1u);
        const unsigned gen = old / nloc;
        if (old + 1u == (gen + 1u) * nloc) {
            __builtin_amdgcn_fence(__ATOMIC_RELEASE, "agent");
            asm volatile("s_waitcnt vmcnt(0)" ::: "memory");
            const unsigned og = xb_add(&bar[XB_TOP], 1u);
            const unsigned tg = og / nx;
            if (og + 1u == (tg + 1u) * nx) xb_add(&bar[XB_TOPGEN], 1u);
            else XB_SPIN(xb_ld(&bar[XB_TOPGEN]) == tg, bar);
            __builtin_amdgcn_fence(__ATOMIC_ACQUIRE, "agent");
            xb_add(&bar[XB_XGEN(b.x)], 1u);
            asm volatile("s_waitcnt vmcnt(0)" ::: "memory");
        } else {
            XB_SPIN(xb_ld(&bar[XB_XGEN(b.x)]) == gen, bar);
            __builtin_amdgcn_fence(__ATOMIC_ACQUIRE, "agent");
            asm volatile("s_waitcnt vmcnt(0)" ::: "memory");
        }
    }
    __syncthreads();
}

__device__ __forceinline__ void fold_phase(const float* Win  , const float* Gm, const float* gain, bf16_t* WINF, float* lds, int G, int bid, int tid) {
    float* Gs = lds;
    float* Ws = lds + 16384;
    for (int it = bid; it < 128; it += G) {
        const int cs = it >> 6, g = (it >> 4) & 3, kb = it & 15, k0 = 64 * kb;
        const float* gsrc = Gm + (size_t)(g * 2 + cs) * 16384;
        for (int i = tid; i < 4096; i += NTHR) *(f32x4*)(Gs + 4 * i) = *(const f32x4*)(gsrc + 4 * i);
        for (int i = tid; i < 64 * 32; i += NTHR) { const int kk = i >> 5, c4 = (i & 31) * 4;
            f32x4 v = *(const f32x4*)(Win + (size_t)(k0 + kk) * 1536 + g * 128 + c4); v = v * gain[k0 + kk];
            *(f32x4*)(Ws + kk * 132 + c4) = v; }
        __syncthreads();
        const int d = tid & 127, kg = tid >> 7;
        float acc[16];
#pragma unroll
        for (int kk = 0; kk < 16; ++kk) acc[kk] = 0.f;
        for (int c = 0; c < 128; c += 4) {
            const float g0 = Gs[(c + 0) * 128 + d], g1 = Gs[(c + 1) * 128 + d], g2 = Gs[(c + 2) * 128 + d], g3 = Gs[(c + 3) * 128 + d];
#pragma unroll
            for (int kk = 0; kk < 16; ++kk) { const f32x4 w4 = *(const f32x4*)(Ws + (kg * 16 + kk) * 132 + c);
                acc[kk] += (w4[0] * g0 + w4[1] * g1) + (w4[2] * g2 + w4[3] * g3); }
        }
        bf16_t* dst = WINF + (size_t)(cs * 512 + g * 128 + d) * 1024 + k0 + kg * 16;
        u32x4 o0, o1;
        o0.x = pk2(acc[0], acc[1]); o0.y = pk2(acc[2], acc[3]); o0.z = pk2(acc[4], acc[5]); o0.w = pk2(acc[6], acc[7]);
        o1.x = pk2(acc[8], acc[9]); o1.y = pk2(acc[10], acc[11]); o1.z = pk2(acc[12], acc[13]); o1.w = pk2(acc[14], acc[15]);
        *(u32x4*)dst = o0; *(u32x4*)(dst + 8) = o1;
        __syncthreads();
    }
}

__global__ void __launch_bounds__(NTHR, 2) mk_fwd(Args a) {
    extern __shared__ __attribute__((aligned(16))) unsigned char lds[];
    cg::grid_group grid = cg::this_grid();
    const int G = gridDim.x, bid = blockIdx.x;
    const int NGW = G * NWAVES;
    const float* norm_g = a.in[2];
    volatile LAS unsigned* MISC = (volatile LAS unsigned*)((LAS unsigned char*)lds + MISC_OFF);
    if (threadIdx.x < 2) MISC[threadIdx.x] = 0u;
    __syncthreads();
    XcdBarrier bar; bar.bar = (unsigned*)(a.ws + WS_BAR); bar.x = 0; bar.st = MISC;

    for (int ph = a.ph_lo; ph < a.ph_hi; ++ph) {
    int tid = threadIdx.x; asm volatile("" : "+v"(tid));
    unsigned char* ws = a.ws; asm volatile("" : "+s"(ws));
    const int lane = tid & 63, wave = __builtin_amdgcn_readfirstlane(tid >> 6);
    const int gw = bid * NWAVES + wave;
    float* SSX = (float*)(ws + WS_SSX); float* SSH = (float*)(ws + WS_SSH); float* SSM = (float*)(ws + WS_SSM); float* GM = (float*)(ws + WS_G);
    bf16_t* MEMB = (bf16_t*)(ws + WS_MEMB);
    bf16_t* XB = (bf16_t*)(ws + WS_XB);
    bf16_t* AR = (bf16_t*)(ws + WS_AR);
    bf16_t* HB = AR;
    bf16_t* PT = AR; bf16_t* CGLU = AR + 16 * MiB; bf16_t* YCAT = AR + 24 * MiB;
    bf16_t* CV = AR; bf16_t* BG = AR + 16 * MiB;
    bf16_t* QB = AR; bf16_t* OB = AR + 16 * MiB;
    bf16_t* CMAT = (bf16_t*)(ws + WS_CMAT);
    bf16_t* WINF = (bf16_t*)(ws + WS_WINF);
        int nj = 0, l = 0, k = -1;
        if (ph == 0) {
            if (bid == 0) for (int i = tid; i < XCD_BAR_WORDS; i += NTHR) ((unsigned*)(ws + WS_BAR))[i] = 0u;
            float* tab = (float*)(lds + TAB_OFF);
            for (int j = tid; j < 2048; j += NTHR) tab[j] = cospif((float)j * (1.0f / 1024.0f));
            __syncthreads();
            for (int it = bid; it < 64; it += G) {
                const int g = it >> 4, cs = (it >> 3) & 1, cb = it & 7, d = tid & 127, ci = tid >> 7;
                const float* Wf = a.in[11] + (size_t)g * 16384;
                float acc[4] = {0.f, 0.f, 0.f, 0.f};
                const int cbase = cb * 16 + ci * 4;
                for (int j = 0; j < 128; ++j) {
                    const float w = Wf[j * 128 + d];
#pragma unroll
                    for (int i = 0; i < 4; ++i) { const int idx = (j * (cbase + i)) & 127; acc[i] += tab[(16 * idx + (cs ? 1536 : 0)) & 2047] * w; }
                }
#pragma unroll
                for (int i = 0; i < 4; ++i) GM[(size_t)(g * 2 + cs) * 16384 + (cbase + i) * 128 + d] = acc[i] * (1.0f / 512.0f);
            }
            for (int kr = gw; kr < SEQ; kr += NGW) {
#pragma unroll
                for (int i = 0; i < 8; ++i) {
                    const int col = i * 512 + lane * 8, cs = col >> 11, s = col & 2047;
                    float v[8];
#pragma unroll
                    for (int e = 0; e < 8; ++e) v[e] = tab[(kr * (s + e) + (cs ? 512 : 0)) & 2047];
                    u32x4 o; o.x = pk2(v[0], v[1]); o.y = pk2(v[2], v[3]); o.z = pk2(v[4], v[5]); o.w = pk2(v[6], v[7]);
                    *(u32x4*)(CMAT + (size_t)kr * 4096 + col) = o;
                }
            }
            for (int row = gw; row < T; row += NGW) row_to_bf16_ss(a.in[0] + (size_t)row * D, XB + (size_t)row * D, SSX + row, lane);
            for (int row = gw; row < MEMT; row += NGW) row_to_bf16_ss(a.in[1] + (size_t)row * D, MEMB + (size_t)row * D, SSM + row, lane);
            float* scr = (float*)(lds + wave * 16384);
            int rotc = 0;
#define CONV_TASK(SRC, LD, KK, N0, NC, DST, INTER, BOFF, GAIN, SCALE) do { \
            const int nblk_ = (NC) / 32, nit_ = ((KK) / 64) * nblk_; \
            for (int it = (gw + NGW - (rotc % NGW)) % NGW; it < nit_; it += NGW) { const int kb_ = it / nblk_, n_ = 32 * (it % nblk_); \
                const int drow_ = (INTER) ? (256 * (n_ >> 7) + (n_ & 127) + (BOFF)) : (n_ + (BOFF)); \
                tr_item((SRC), (LD), (KK), (N0) + n_, (DST), drow_, (GAIN), (SCALE), scr, kb_, lane); } \
            rotc += nit_; } while (0)
            for (int ll = 0; ll < 2; ++ll) {
                for (int j = 0; j < 2; ++j) {
                    bf16_t* wgu = (bf16_t*)(ws + WS_W + (size_t)(ll * 2 + j) * (16 * MiB + MiB / 2));
                    bf16_t* wd = wgu + (size_t)5632 * 1024;
                    const float* gn = norm_g + (size_t)(ll * 8 + (j ? 6 : 0)) * D;
                    const size_t wo = (size_t)(ll * 2 + j) * D * FF;
                    CONV_TASK(a.in[4] + wo, FF, D, 0, FF, wgu, 1, 0, gn, 1.0f);
                    CONV_TASK(a.in[5] + wo, FF, D, 0, FF, wgu, 1, 128, gn, 1.0f);
                    CONV_TASK(a.in[6] + wo, D, FF, 0, D, wd, 0, 0, (const float*)nullptr, 1.0f);
                }
                bf16_t* wq = (bf16_t*)(ws + WS_WQ + (size_t)ll * 8 * MiB);
                CONV_TASK(a.in[7] + (size_t)ll * D * D, D, D, 0, D, wq, 0, 0, norm_g + (size_t)(ll * 8 + 4) * D, 0.0625f);
                CONV_TASK(a.in[8] + (size_t)ll * D * 2 * D, 2 * D, D, 0, 2 * D, wq + (size_t)D * D, 0, 0, a.in[3] + (size_t)ll * D, 1.0f);
                CONV_TASK(a.in[9] + (size_t)ll * D * D, D, D, 0, D, wq + (size_t)3 * D * D, 0, 0, (const float*)nullptr, 1.0f);
            }
            CONV_TASK(a.in[10], 1536, D, 512, 512, (bf16_t*)(ws + WS_WINVG), 1, 0, norm_g + 2 * D, 1.0f);
            CONV_TASK(a.in[10], 1536, D, 1024, 512, (bf16_t*)(ws + WS_WINVG), 1, 128, norm_g + 2 * D, 1.0f);
            CONV_TASK(a.in[16], D, D, 0, D, (bf16_t*)(ws + WS_WOUTEV), 0, 0, (const float*)nullptr, 1.0f);
            CONV_TASK(a.in[17], 3 * D, D, 0, D, (bf16_t*)(ws + WS_WINB), 0, 0, norm_g + (8 + 2) * D, 1.0f);
            CONV_TASK(a.in[17], 3 * D, D, D, D, (bf16_t*)(ws + WS_WINCV), 1, 0, norm_g + (8 + 2) * D, 1.0f);
            CONV_TASK(a.in[17], 3 * D, D, 2 * D, D, (bf16_t*)(ws + WS_WINCV), 1, 128, norm_g + (8 + 2) * D, 1.0f);
            CONV_TASK(a.in[19], D, D, 0, D, (bf16_t*)(ws + WS_WOUTOD), 0, 0, (const float*)nullptr, 1.0f);
#undef CONV_TASK
        } else {
            l = (ph - 1) / 14; k = (ph - 1) % 14;
            const float* gl = norm_g + (size_t)l * 8 * D;
            if (k == 2 || k == 6 || k == 10 || k == 13) {
                const float* xin = (l == 0 && k == 2) ? a.in[0] : a.out;
                const int gi = (k == 2) ? 1 : (k == 6) ? 3 : (k == 10) ? 5 : 7;
                resid_phase(xin, a.out, XB, SSH, SSX, gl + gi * D, (k == 2 || k == 13) ? 0.5f : 1.0f, gw, NGW, lane);
                if (k == 2 && l == 0) fold_phase(a.in[10], GM, norm_g + 2 * D, WINF, (float*)lds, G, bid, tid);
            } else if (k == 8) {
                attn_phase(QB, (const bf16_t*)(ws + WS_KV + (size_t)l * 8 * MiB), (const bf16_t*)(ws + WS_KV + (size_t)l * 8 * MiB + 4 * MiB), OB, G, bid, wave, lane);
            } else if (k == 4) {
                if (l == 0) { nj = 1; convln_phase(CGLU, YCAT, a.in[12], a.in[13], a.in[14], a.in[15], (float*)lds, G / 2, G - G / 2, bid, tid); }
                else conv3_phase(CV, BG, a.in[18], gw, NGW, lane);
            } else if (k == 0) nj = (l == 0) ? 5 : 1;
            else if (k == 3) nj = 2;
            else nj = 1;
        }
        for (int j = 0; j < nj; ++j) {
            pg8::Gemm g; pg8::EpiG E; int rot = 0;
            g.a_mod = 1 << 20; g.M = T; g.N = D; g.K = D; g.A = XB; g.Bt = XB;
            E.mode = 0; E.act = 0; E.O = XB; E.ldc = D; E.ss = nullptr; E.ssout = SSH; E.cdiv = 1 << 20; E.cbatch = 0; E.rdiv = 1 << 20; E.rsplit = 0;
            const int fj = (k >= 11) ? 1 : 0;
            bf16_t* wgu = (bf16_t*)(ws + WS_W + (size_t)(l * 2 + fj) * (16 * MiB + MiB / 2));
            bf16_t* wq = (bf16_t*)(ws + WS_WQ + (size_t)l * 8 * MiB);
            if (k == 0 || k == 11) {
                if (j == 0) { g.A = XB; g.Bt = wgu; g.N = 2 * FF; E.mode = 1; E.act = 0; E.O = HB; E.ldc = FF; E.ss = SSX; }
                else { const int jj = j - 1, ll = jj >> 1; bf16_t* wkv = (bf16_t*)(ws + WS_WQ + (size_t)ll * 8 * MiB) + (size_t)D * D;
                    bf16_t* kb = (bf16_t*)(ws + WS_KV + (size_t)ll * 8 * MiB);
                    rot = 128 + 32 * jj; E.ss = SSM;
                    if ((jj & 1) == 0) { g.A = MEMB; g.Bt = wkv; g.M = MEMT; g.N = D; E.mode = 0; E.O = kb; E.ldc = D; }
                    else { g.A = wkv + (size_t)D * D; g.Bt = MEMB; g.M = D; g.N = MEMT; E.mode = 3; E.O = kb + 2 * MiB; E.ldc = MEMT; } }
            } else if (k == 1 || k == 12) { g.A = HB; g.Bt = wgu + (size_t)5632 * 1024; g.K = FF; E.mode = 2; E.O = XB; }
            else if (k == 3) {
                if (l == 0) {
                    if (j == 0) { g.A = WINF; g.Bt = XB; g.M = D; g.N = T; E.mode = 3; E.O = PT; E.ldc = 4096; E.ss = SSX; E.cdiv = 8; E.cbatch = 512 * 4096; E.rdiv = 2; E.rsplit = 2048; }
                    else { g.Bt = (bf16_t*)(ws + WS_WINVG); E.mode = 1; E.act = 1; E.O = CGLU; E.ldc = 512; E.ss = SSX; }
                } else {
                    if (j == 0) { g.Bt = (bf16_t*)(ws + WS_WINCV); g.N = 2 * D; E.mode = 1; E.act = 2; E.O = CV; E.ldc = D; E.ss = SSX; }
                    else { g.Bt = (bf16_t*)(ws + WS_WINB); E.mode = 0; E.O = BG; E.ss = SSX; }
                }
            } else if (k == 4) { g.A = CMAT; g.Bt = PT; g.N = 512; g.K = 4096; g.a_mod = 8; E.mode = 0; E.O = YCAT; }
            else if (k == 5) { g.A = (l == 0) ? YCAT : BG; g.Bt = (bf16_t*)(ws + ((l == 0) ? WS_WOUTEV : WS_WOUTOD)); E.mode = 2; E.O = XB; }
            else if (k == 7) { g.Bt = wq; E.mode = 0; E.O = QB; E.ss = SSX; }
            else { g.A = OB; g.Bt = wq + (size_t)3 * D * D; E.mode = 2; E.O = XB; }
            pg8::StaticOrder S; S.init(g.M, g.N, G, (bid + G - rot) % G);
            pg8::gemm_phase<pg8::EpiG, pg8::StaticOrder, true, true>((PG8_LAS unsigned char*)lds, g, S, E);
        }
        if (ph + 1 < a.ph_hi) {
            if (ph == 0) { grid.sync(); bar = xcd_barrier_post((unsigned*)(a.ws + WS_BAR), MISC); }
            else xcd_barrier(bar);
        }
    }
}

extern "C" void kernel_launch(void* const* d_in, const int* in_sizes, int n_in, void* d_out, int out_size, void* d_ws, size_t ws_size, hipStream_t stream) {
    static int grid = 0;
    if (grid == 0) {
        if (n_in != 20 || out_size != T * D || ws_size < WS_END) { fprintf(stderr, "kernel_launch: unexpected shapes n_in %d out %d ws %zu\n", n_in, out_size, ws_size); grid = -1; return; }
        int dev = 0, cus = 0, per_cu = 0;
        hipGetDevice(&dev);
        hipDeviceGetAttribute(&cus, hipDeviceAttributeMultiprocessorCount, dev);
        if (hipFuncSetAttribute((const void*)mk_fwd, hipFuncAttributeMaxDynamicSharedMemorySize, LDS_BYTES) != hipSuccess) { fprintf(stderr, "kernel_launch: hipFuncSetAttribute failed\n"); grid = -1; return; }
        if (hipOccupancyMaxActiveBlocksPerMultiprocessor(&per_cu, (const void*)mk_fwd, NTHR, LDS_BYTES) != hipSuccess || per_cu < 1) { fprintf(stderr, "kernel_launch: occupancy query gave %d\n", per_cu); per_cu = 1; }
        (void)hipGetLastError();
        grid = cus;
    }
    if (grid < 0) return;
    Args a{};
    for (int i = 0; i < 20; ++i) a.in[i] = (const float*)d_in[i];
    a.out = (float*)d_out; a.ws = (unsigned char*)d_ws;
#if MK_PER_PHASE
    for (int p = 0; p < NPHASE; ++p) { a.ph_lo = p; a.ph_hi = p + 1; hipLaunchKernelGGL(mk_fwd, dim3(grid), dim3(NTHR), LDS_BYTES, stream, a); }
#else
    a.ph_lo = 0; a.ph_hi = NPHASE;
    void* args[] = {&a};
    hipError_t e = hipLaunchCooperativeKernel((const void*)mk_fwd, dim3(grid), dim3(NTHR), args, LDS_BYTES, stream);
    if (e != hipSuccess) fprintf(stderr, "cooperative launch failed: %s (grid %d)\n", hipGetErrorString(e), grid);
#endif
}
```
